# Optimizing an MI355X kernel written in HIP

```python
import math
import jax, jax.numpy as jnp
from jax import lax
import numpy as np

D_MODEL = 1024
BATCH = 4
SEQ = 8192
DEPTH = 1
DEC_BATCH = 128
DEC_SEQ = 4
PAST_LEN = 16384
PAGE_SIZE = 128

SSM_WIDTH = D_MODEL // 2
SSM_GROUP = 16
N_SSM_GROUPS = SSM_WIDTH // SSM_GROUP
SSM_STATE = 64
SSM_BLOCK = 128

HEAD_DIM = 64
ATTN_WIDTH = D_MODEL - SSM_WIDTH
N_HEADS = ATTN_WIDTH // HEAD_DIM
N_KV_HEADS = 2
GQA_GROUP = N_HEADS // N_KV_HEADS
Q_WIDTH = N_HEADS * HEAD_DIM
KV_WIDTH = N_KV_HEADS * HEAD_DIM
WINDOW = 128
ROPE_THETA = 500000.0
ROPE_DIM = HEAD_DIM // 4

N_MEM = 256
MEM_HEADS = 4
MEM_HEAD_DIM = D_MODEL // MEM_HEADS

D_FF = 2816
RMS_EPS = 1e-6
IN_WIDTH = SSM_WIDTH + Q_WIDTH + 2 * KV_WIDTH
NEG_INF = -1e30

kernel_name = "hymba_s5_swa_sink_macaron_memory_step"


def rms_norm(x, g):
    xf = x.astype(jnp.float32)
    y = xf * lax.rsqrt(jnp.mean(xf * xf, axis=-1, keepdims=True) + RMS_EPS)
    return (y * g.astype(jnp.float32)).astype(x.dtype)


def swiglu(x, w_gate, w_up, w_down):
    return (jax.nn.silu(x @ w_gate) * (x @ w_up)) @ w_down


def rope_partial(x, pos):
    half = ROPE_DIM // 2
    inv = ROPE_THETA ** (-jnp.arange(half, dtype=jnp.float32) * (2.0 / ROPE_DIM))
    ang = pos.astype(jnp.float32)[:, None] * inv[None, :]
    cos = jnp.cos(ang)[:, None, :]
    sin = jnp.sin(ang)[:, None, :]
    xr = x[..., :ROPE_DIM].astype(jnp.float32)
    x1, x2 = xr[..., :half], xr[..., half:]
    rot = jnp.concatenate([x1 * cos - x2 * sin, x2 * cos + x1 * sin], axis=-1)
    return jnp.concatenate([rot.astype(x.dtype), x[..., ROPE_DIM:]], axis=-1)


def sink_softmax(sc, sink):
    sink = sink.astype(jnp.float32)
    m = jnp.maximum(jnp.max(sc, axis=-1, keepdims=True), sink)
    e = jnp.exp(sc - m)
    return e / (jnp.sum(e, axis=-1, keepdims=True) + jnp.exp(sink - m))


def s5_discretise(a_re, a_im, log_step, b_re, b_im):
    f32 = jnp.float32
    a_re, a_im = a_re.astype(f32), a_im.astype(f32)
    dt = jnp.exp(log_step.astype(f32))[:, None]
    mag = jnp.exp(a_re * dt)
    lb_re, lb_im = mag * jnp.cos(a_im * dt), mag * jnp.sin(a_im * dt)
    den = a_re * a_re + a_im * a_im
    n_re, n_im = lb_re - 1.0, lb_im
    c_re = (n_re * a_re + n_im * a_im) / den
    c_im = (n_im * a_re - n_re * a_im) / den
    b_re, b_im = b_re.astype(f32), b_im.astype(f32)
    bb_re = c_re[..., None] * b_re - c_im[..., None] * b_im
    bb_im = c_re[..., None] * b_im + c_im[..., None] * b_re
    return lb_re, lb_im, bb_re, bb_im


def _ssm_combine(e1, e2):
    a1r, a1i, b1r, b1i = e1
    a2r, a2i, b2r, b2i = e2
    return (a1r * a2r - a1i * a2i, a1r * a2i + a1i * a2r,
            a2r * b1r - a2i * b1i + b2r, a2r * b1i + a2i * b1r + b2i)


def s5_scan(u, s0_re, s0_im, lb_re, lb_im, bb_re, bb_im, c_re, c_im, d):
    n, L, _ = u.shape
    blk = math.gcd(L, SSM_BLOCK)
    nblk = L // blk
    ub = u.reshape(n, nblk, blk, N_SSM_GROUPS, SSM_GROUP).swapaxes(0, 1)
    a_re = jnp.broadcast_to(lb_re, (n, blk, N_SSM_GROUPS, SSM_STATE))
    a_im = jnp.broadcast_to(lb_im, (n, blk, N_SSM_GROUPS, SSM_STATE))

    def step(carry, u_blk):
        sr, si = carry
        bu_re = jnp.einsum('nlgh,gph->nlgp', u_blk, bb_re)
        bu_im = jnp.einsum('nlgh,gph->nlgp', u_blk, bb_im)
        bu_re = bu_re.at[:, 0].add(lb_re * sr - lb_im * si)
        bu_im = bu_im.at[:, 0].add(lb_re * si + lb_im * sr)
        _, _, hr, hi = lax.associative_scan(_ssm_combine, (a_re, a_im, bu_re, bu_im), axis=1)
        y = (jnp.einsum('nlgp,ghp->nlgh', hr, c_re)
             - jnp.einsum('nlgp,ghp->nlgh', hi, c_im)
             + d[None, None] * u_blk)
        return (hr[:, -1], hi[:, -1]), y

    (sr, si), ys = lax.scan(step, (s0_re, s0_im), ub)
    y = ys.swapaxes(0, 1).reshape(n, L, SSM_WIDTH)
    return y, sr, si


def swa_prompt(q, k, v, sinks):
    n, s = q.shape[:2]
    nb = s // WINDOW
    qb = q.reshape(n, nb, WINDOW, N_KV_HEADS, GQA_GROUP, HEAD_DIM)

    def band(t):
        tb = t.reshape(n, nb, WINDOW, N_KV_HEADS, HEAD_DIM)
        prev = jnp.concatenate([jnp.zeros_like(tb[:, :1]), tb[:, :-1]], axis=1)
        return jnp.concatenate([prev, tb], axis=2)

    kk, vv = band(k), band(v)
    qi = jnp.arange(WINDOW)[:, None] + WINDOW
    kj = jnp.arange(2 * WINDOW)[None, :]
    diff = qi - kj
    blk = jnp.arange(nb)[:, None, None]
    mask = (diff >= 0) & (diff <= WINDOW) & (blk * WINDOW + kj - WINDOW >= 0)
    sc = jnp.einsum('bnqkgd,bnskd->bnkgqs', qb, kk).astype(jnp.float32) * (HEAD_DIM ** -0.5)
    sc = jnp.where(mask[None, :, None, None], sc, NEG_INF)
    pr = sink_softmax(sc, sinks.reshape(N_KV_HEADS, GQA_GROUP, 1, 1))
    o = jnp.einsum('bnkgqs,bnskd->bnqkgd', pr.astype(vv.dtype), vv)
    w = min(WINDOW, s)
    return o.reshape(n, s, Q_WIDTH), k[:, -w:], v[:, -w:]


def swa_sample(q, k, v, win_k, win_v, sinks):
    n, t = q.shape[:2]
    wb = win_k.shape[1]
    kk = jnp.concatenate([win_k.astype(k.dtype), k], axis=1)
    vv = jnp.concatenate([win_v.astype(v.dtype), v], axis=1)
    qb = q.reshape(n, t, N_KV_HEADS, GQA_GROUP, HEAD_DIM)
    diff = (wb + jnp.arange(t))[:, None] - jnp.arange(wb + t)[None, :]
    mask = (diff >= 0) & (diff <= WINDOW)
    sc = jnp.einsum('btkgd,bskd->bkgts', qb, kk).astype(jnp.float32) * (HEAD_DIM ** -0.5)
    sc = jnp.where(mask, sc, NEG_INF)
    pr = sink_softmax(sc, sinks.reshape(N_KV_HEADS, GQA_GROUP, 1, 1))
    o = jnp.einsum('bkgts,bskd->btkgd', pr.astype(vv.dtype), vv)
    return (o.reshape(n, t, Q_WIDTH), kk[:, t:].astype(win_k.dtype), vv[:, t:].astype(win_v.dtype))


def memory_kv(mem, g, w_k, w_v):
    n = mem.shape[0]
    m = rms_norm(mem, g)
    mk = (m @ w_k).reshape(n, N_MEM, MEM_HEADS, MEM_HEAD_DIM)
    mv = (m @ w_v).reshape(n, N_MEM, MEM_HEADS, MEM_HEAD_DIM)
    return mk, mv


def memory_attend(h, mk, mv, w_q, w_o):
    n, L, _ = h.shape
    q = (h @ w_q).reshape(n, L, MEM_HEADS, MEM_HEAD_DIM)
    sc = jnp.einsum('blhd,bmhd->bhlm', q, mk.astype(q.dtype)).astype(jnp.float32) * (MEM_HEAD_DIM ** -0.5)
    pr = jax.nn.softmax(sc, axis=-1)
    o = jnp.einsum('bhlm,bmhd->blhd', pr.astype(h.dtype), mv.astype(h.dtype))
    return o.reshape(n, L, D_MODEL) @ w_o


def decoder_layer(x, pos, s0_re, s0_im, win_k, win_v, mem_k, mem_v, p):
    f32 = jnp.float32
    n, L, _ = x.shape
    h = x
    h = h + 0.5 * rms_norm(swiglu(rms_norm(h, p['ffn1_pre_g']), p['ffn1_w_gate'], p['ffn1_w_up'],
                                  p['ffn1_w_down']), p['ffn1_post_g'])
    z = rms_norm(h, p['mix_pre_g']) @ p['w_in']
    u = z[..., :SSM_WIDTH]
    o1 = SSM_WIDTH + Q_WIDTH
    q = z[..., SSM_WIDTH:o1].reshape(n, L, N_HEADS, HEAD_DIM)
    k = z[..., o1:o1 + KV_WIDTH].reshape(n, L, N_KV_HEADS, HEAD_DIM)
    v = z[..., o1 + KV_WIDTH:].reshape(n, L, N_KV_HEADS, HEAD_DIM)
    lb_re, lb_im, bb_re, bb_im = s5_discretise(p['ssm_a_re'], p['ssm_a_im'], p['ssm_log_step'],
                                               p['ssm_b_re'], p['ssm_b_im'])
    y, s_re, s_im = s5_scan(u.astype(f32), s0_re.astype(f32), s0_im.astype(f32),
                            lb_re, lb_im, bb_re, bb_im,
                            p['ssm_c_re'].astype(f32), p['ssm_c_im'].astype(f32),
                            p['ssm_d'].astype(f32).reshape(N_SSM_GROUPS, SSM_GROUP))
    g = jax.nn.gelu(y)
    y_ssm = (g * jax.nn.sigmoid(g @ p['ssm_w_glu'].astype(f32) + p['ssm_b_glu'].astype(f32))).astype(x.dtype)
    q = rope_partial(q, pos)
    k = rope_partial(k, pos)
    if win_k is None:
        o, nk, nv = swa_prompt(q, k, v, p['attn_sinks'])
    else:
        o, nk, nv = swa_sample(q, k, v, win_k, win_v, p['attn_sinks'])
    mixed = jnp.concatenate([rms_norm(y_ssm, p['ssm_out_g']), rms_norm(o, p['attn_out_g'])], axis=-1) @ p['w_out']
    h = h + rms_norm(mixed, p['mix_post_g'])
    c = memory_attend(rms_norm(h, p['xa_pre_g']), mem_k, mem_v, p['w_mem_q'], p['w_mem_o'])
    h = h + rms_norm(c, p['xa_post_g'])
    h = h + 0.5 * rms_norm(swiglu(rms_norm(h, p['ffn2_pre_g']), p['ffn2_w_gate'], p['ffn2_w_up'],
                                  p['ffn2_w_down']), p['ffn2_post_g'])
    return h, s_re.astype(s0_re.dtype), s_im.astype(s0_im.dtype), nk, nv


def setup_inputs(seed: int = 0) -> dict:
    key = jax.random.key(seed)
    keys = jax.random.split(key, 64)
    ctr = [0]
    f32 = jnp.float32

    def nk():
        ctr[0] += 1
        return keys[ctr[0]]

    def normal(shape, scale):
        return scale * jax.random.normal(nk(), shape, f32)

    def gain(m):
        return 1.0 + normal((m,), 0.01)

    win = min(WINDOW, PAST_LEN)
    G, P, H = N_SSM_GROUPS, SSM_STATE, SSM_GROUP
    d_in = D_MODEL ** -0.5
    return {
        'x_prompt': normal((BATCH, SEQ, D_MODEL), 1.0),
        'x_sample': normal((DEC_BATCH, DEC_SEQ, D_MODEL), 1.0),
        'state_ssm_re': normal((DEC_BATCH, G, P), 0.3),
        'state_ssm_im': normal((DEC_BATCH, G, P), 0.3),
        'cache_swa_k': normal((DEC_BATCH, win, N_KV_HEADS, HEAD_DIM), 1.0),
        'cache_swa_v': normal((DEC_BATCH, win, N_KV_HEADS, HEAD_DIM), 1.0),
        'cache_mem_k': normal((DEC_BATCH, N_MEM, MEM_HEADS, MEM_HEAD_DIM), 1.0),
        'cache_mem_v': normal((DEC_BATCH, N_MEM, MEM_HEADS, MEM_HEAD_DIM), 1.0),
        'mem_prompt': normal((BATCH, N_MEM, D_MODEL), 1.0),
        'ffn1_pre_g': gain(D_MODEL),
        'ffn1_w_gate': normal((D_MODEL, D_FF), d_in),
        'ffn1_w_up': normal((D_MODEL, D_FF), d_in),
        'ffn1_w_down': normal((D_FF, D_MODEL), D_FF ** -0.5),
        'ffn1_post_g': gain(D_MODEL),
        'mix_pre_g': gain(D_MODEL),
        'w_in': normal((D_MODEL, IN_WIDTH), d_in),
        'ssm_a_re': -0.5 + normal((G, P), 0.01),
        'ssm_a_im': math.pi * jnp.broadcast_to(jnp.arange(P, dtype=f32), (G, P)) + normal((G, P), 0.01),
        'ssm_log_step': jax.random.uniform(nk(), (G,), f32, math.log(1e-3), math.log(1e-1)),
        'ssm_b_re': normal((G, P, H), (2 * H) ** -0.5),
        'ssm_b_im': normal((G, P, H), (2 * H) ** -0.5),
        'ssm_c_re': normal((G, H, P), (2 * P) ** -0.5),
        'ssm_c_im': normal((G, H, P), (2 * P) ** -0.5),
        'ssm_d': normal((SSM_WIDTH,), 1.0),
        'ssm_w_glu': normal((SSM_WIDTH, SSM_WIDTH), SSM_WIDTH ** -0.5),
        'ssm_b_glu': normal((SSM_WIDTH,), 0.01),
        'attn_sinks': normal((N_HEADS,), 0.5),
        'ssm_out_g': gain(SSM_WIDTH),
        'attn_out_g': gain(Q_WIDTH),
        'w_out': normal((SSM_WIDTH + Q_WIDTH, D_MODEL), (SSM_WIDTH + Q_WIDTH) ** -0.5),
        'mix_post_g': gain(D_MODEL),
        'mem_norm_g': gain(D_MODEL),
        'w_mem_q': normal((D_MODEL, D_MODEL), d_in),
        'w_mem_k': normal((D_MODEL, D_MODEL), d_in),
        'w_mem_v': normal((D_MODEL, D_MODEL), d_in),
        'w_mem_o': normal((D_MODEL, D_MODEL), d_in),
        'xa_pre_g': gain(D_MODEL),
        'xa_post_g': gain(D_MODEL),
        'ffn2_pre_g': gain(D_MODEL),
        'ffn2_w_gate': normal((D_MODEL, D_FF), d_in),
        'ffn2_w_up': normal((D_MODEL, D_FF), d_in),
        'ffn2_w_down': normal((D_FF, D_MODEL), D_FF ** -0.5),
        'ffn2_post_g': gain(D_MODEL),
    }


def reference(x_prompt, x_sample, state_ssm_re, state_ssm_im, cache_swa_k, cache_swa_v,
              cache_mem_k, cache_mem_v, mem_prompt,
              ffn1_pre_g, ffn1_w_gate, ffn1_w_up, ffn1_w_down, ffn1_post_g,
              mix_pre_g, w_in, ssm_a_re, ssm_a_im, ssm_log_step, ssm_b_re, ssm_b_im,
              ssm_c_re, ssm_c_im, ssm_d, ssm_w_glu, ssm_b_glu, attn_sinks,
              ssm_out_g, attn_out_g, w_out, mix_post_g,
              mem_norm_g, w_mem_q, w_mem_k, w_mem_v, w_mem_o, xa_pre_g, xa_post_g,
              ffn2_pre_g, ffn2_w_gate, ffn2_w_up, ffn2_w_down, ffn2_post_g):
    p = dict(ffn1_pre_g=ffn1_pre_g, ffn1_w_gate=ffn1_w_gate, ffn1_w_up=ffn1_w_up,
             ffn1_w_down=ffn1_w_down, ffn1_post_g=ffn1_post_g,
             mix_pre_g=mix_pre_g, w_in=w_in, ssm_a_re=ssm_a_re, ssm_a_im=ssm_a_im,
             ssm_log_step=ssm_log_step, ssm_b_re=ssm_b_re, ssm_b_im=ssm_b_im,
             ssm_c_re=ssm_c_re, ssm_c_im=ssm_c_im, ssm_d=ssm_d, ssm_w_glu=ssm_w_glu,
             ssm_b_glu=ssm_b_glu, attn_sinks=attn_sinks, ssm_out_g=ssm_out_g,
             attn_out_g=attn_out_g, w_out=w_out, mix_post_g=mix_post_g,
             w_mem_q=w_mem_q, w_mem_o=w_mem_o, xa_pre_g=xa_pre_g, xa_post_g=xa_post_g,
             ffn2_pre_g=ffn2_pre_g, ffn2_w_gate=ffn2_w_gate, ffn2_w_up=ffn2_w_up,
             ffn2_w_down=ffn2_w_down, ffn2_post_g=ffn2_post_g)
    n_p, s_p, _ = x_prompt.shape
    n_s, t_s, _ = x_sample.shape
    pm_k, pm_v = memory_kv(mem_prompt, mem_norm_g, w_mem_k, w_mem_v)
    h_p = x_prompt
    h_s = x_sample
    for _ in range(DEPTH):
        z0 = jnp.zeros((n_p, N_SSM_GROUPS, SSM_STATE), x_prompt.dtype)
        h_p, p_sre, p_sim, p_wk, p_wv = decoder_layer(
            h_p, jnp.arange(s_p, dtype=jnp.int32), z0, z0, None, None, pm_k, pm_v, p)
        h_s, s_sre, s_sim, s_wk, s_wv = decoder_layer(
            h_s, PAST_LEN + jnp.arange(t_s, dtype=jnp.int32), state_ssm_re, state_ssm_im,
            cache_swa_k, cache_swa_v, cache_mem_k, cache_mem_v, p)
    return (h_p, h_s, p_sre, p_sim, p_wk, p_wv, pm_k, pm_v, s_sre, s_sim, s_wk, s_wv)
```

```cpp
#include <hip/hip_runtime.h>
#include <cstdio>
#include <cstdint>
namespace pg8 {
#define PG8_LAS __attribute__((address_space(3)))
typedef unsigned short bf16_t;
typedef short bf16x8 __attribute__((ext_vector_type(8)));
typedef float f32x4 __attribute__((ext_vector_type(4)));
typedef unsigned u32x4 __attribute__((ext_vector_type(4)));
constexpr int BM = 256, BK = 64, HALF = 128, HTB = HALF * BK * 2  , STAGE_BYTES = 8 * HTB, NXCD = 8, WGM = 8;

__host__ __device__ __forceinline__ int lds_byte(int r, int c) { const int st = (r >> 4) * 2 + (c >> 5), rr = r & 15, cc = c & 31, ob = rr * 64 + cc * 2; return st * 1024 + (ob ^ (((ob >> 9) & 1) << 5)); }
__host__ __device__ __forceinline__ void stage_rc(int b, int& R, int& C) { const int st = b / 1024, sb = b % 1024, swz = sb ^ (((sb >> 9) & 1) << 5); R = (st >> 1) * 16 + swz / 64; C = (st & 1) * 32 + (swz % 64) / 2; }
__host__ __device__ __forceinline__ int perm32(int rho) { const int n = rho >> 4, i = rho & 15; return 8 * (i >> 2) + 4 * n + (i & 3); }

struct Unit { int pm, pn; };
struct Gemm { const bf16_t* A; const bf16_t* Bt; int M, N, K; };

struct StaticOrder {
    int nM, nN, nwg, G, c;
    __host__ __device__ void init(int M, int N, int G_, int c_) { nM = M / BM; nN = N / BM; nwg = nM * nN; G = G_; c = c_; }
    __host__ __device__ bool next(int i, Unit& u) const {
        const long L = (long)i * G + c; if (L >= nwg) return false;
        int wgid = (int)L; { const int q = nwg / NXCD, r = nwg % NXCD, xcd = wgid % NXCD, off = wgid / NXCD; wgid = (xcd < r ? xcd * (q + 1) : r * (q + 1) + (xcd - r) * q) + off; }
        const int nig = WGM * nN, gid = wgid / nig, fm = gid * WGM, gsz = (nM - fm) < WGM ? (nM - fm) : WGM;
        u.pm = fm + ((wgid % nig) % gsz); u.pn = (wgid % nig) / gsz; return true;
    }
    __device__ __forceinline__ void a_ready(const Unit&) const {}
    __device__ __forceinline__ void done(const Unit&) const {}
};

__device__ __forceinline__ unsigned cvt_pk_bf16(float lo, float hi) { unsigned r; asm volatile("v_cvt_pk_bf16_f32 %0, %1, %2" : "=v"(r) : "v"(lo), "v"(hi)); return r; }
typedef float f32x2 __attribute__((ext_vector_type(2)));
__device__ __forceinline__ f32x2 gelu_pk(f32x2 v) {
    const f32x2 av = __builtin_elementwise_abs(v), d = av * 0.2316418882f + 1.0f;
    f32x2 t; t.x = __builtin_amdgcn_rcpf(d.x); t.y = __builtin_amdgcn_rcpf(d.y);
    f32x2 q = t * 0.5307027145f + (-0.7265760135f); q = q * t + 0.7107068705f; q = q * t + (-0.142248368f); q = q * t + 0.127414796f; q = q * t;
    const f32x2 s = (v * v) * (-0.72134752044f);
    f32x2 e; e.x = __builtin_amdgcn_exp2f(s.x); e.y = __builtin_amdgcn_exp2f(s.y);
    const f32x2 m = v * (q * e), r = v - m;
    f32x2 o; o.x = v.x < 0.f ? m.x : r.x; o.y = v.y < 0.f ? m.y : r.y; return o;
}

template <int ACT  > struct EpiBf16 {
    static constexpr bool PERM = true, AFTER_DRAIN = false; static_assert(ACT == 0 || ACT == 1, "EpiBf16: ACT is 0 (none) or 1 (gelu_pk)");
    bf16_t* O; int ldc; const float* bias; int split_cols; size_t split_stride; float scale0;
    __device__ __forceinline__ void operator()(const f32x4 (&acc)[2][2][4][2], const Unit& u, int wr, int wc, int fr, int fq) const {
        const int row0 = u.pm * BM + wr * 64 + fr; int colt = u.pn * BM; bf16_t* base = O;
        float sc = 1.f; if (split_cols) { const int t = colt / split_cols; base += (size_t)t * split_stride; colt -= t * split_cols; if (t == 0) sc = scale0; }
        const int col0 = colt + wc * 32 + 8 * fq, bcol0 = u.pn * BM + wc * 32 + 8 * fq;
        f32x4 bv[2][2];
#pragma unroll
        for (int bj = 0; bj < 2; ++bj)
#pragma unroll
            for (int n = 0; n < 2; ++n) bv[bj][n] = bias ? *(const f32x4*)(bias + bcol0 + bj * HALF + 4 * n) : (f32x4){0.f, 0.f, 0.f, 0.f};
#pragma unroll
        for (int ai = 0; ai < 2; ++ai)
#pragma unroll
            for (int m = 0; m < 4; ++m) { bf16_t* rowp = base + (size_t)(row0 + ai * HALF + m * 16) * ldc + col0;
#pragma unroll
                for (int bj = 0; bj < 2; ++bj) { f32x4 v0 = acc[ai][bj][m][0] + bv[bj][0], v1 = acc[ai][bj][m][1] + bv[bj][1];
                    if (ACT == 1) { f32x2 a = gelu_pk((f32x2){v0[0], v0[1]}), b = gelu_pk((f32x2){v0[2], v0[3]}), c = gelu_pk((f32x2){v1[0], v1[1]}), d = gelu_pk((f32x2){v1[2], v1[3]});
                        v0 = (f32x4){a.x, a.y, b.x, b.y}; v1 = (f32x4){c.x, c.y, d.x, d.y}; }
                    v0 = v0 * sc; v1 = v1 * sc; u32x4 w; w.x = cvt_pk_bf16(v0[0], v0[1]); w.y = cvt_pk_bf16(v0[2], v0[3]); w.z = cvt_pk_bf16(v1[0], v1[1]); w.w = cvt_pk_bf16(v1[2], v1[3]);
                    *(u32x4*)(rowp + bj * HALF) = w; } }
    }
};

struct PanelStats {
    unsigned* xbuf;
    unsigned* cnt;
    unsigned* tmo;
    int ntn; float eps;
    unsigned code;
    __device__ __forceinline__ bool run(const f32x4 (&v)[2][2][4][2], const Unit& u, int wr, int wc, int fr, int fq, PG8_LAS unsigned char* lds, int wid, int lane) const {
        typedef float f32x2v __attribute__((ext_vector_type(2)));
        PG8_LAS f32x2v* P = (PG8_LAS f32x2v*)lds;
        PG8_LAS f32x2v* S = (PG8_LAS f32x2v*)(lds + 8192);
        PG8_LAS unsigned* flag = (PG8_LAS unsigned*)(lds + 8192 + 2048);
#pragma unroll
        for (int ai = 0; ai < 2; ++ai)
#pragma unroll
            for (int m = 0; m < 4; ++m) {
                float s = 0.f;
#pragma unroll
                for (int bj = 0; bj < 2; ++bj)
#pragma unroll
                    for (int n = 0; n < 2; ++n) { const f32x4 x = v[ai][bj][m][n]; s += (x[0] + x[1]) + (x[2] + x[3]); }
                s += __shfl_xor(s, 16); s += __shfl_xor(s, 32);
                const float mw = s * (1.0f / 64.0f); float q = 0.f;
#pragma unroll
                for (int bj = 0; bj < 2; ++bj)
#pragma unroll
                    for (int n = 0; n < 2; ++n) { const f32x4 d = v[ai][bj][m][n] - mw; q += (d[0] * d[0] + d[1] * d[1]) + (d[2] * d[2] + d[3] * d[3]); }
                q += __shfl_xor(q, 16); q += __shfl_xor(q, 32);
                if (fq == 0) P[(ai * HALF + wr * 64 + m * 16 + fr) * 4 + wc] = (f32x2v){mw, q};
            }
        asm volatile("s_waitcnt lgkmcnt(0)" ::: "memory"); __builtin_amdgcn_s_barrier(); asm volatile("" ::: "memory");
#if defined(BROKEN_EXCHANGE_NO_WAIT)
#warning BROKEN CONTROL BUILD: the row-statistics exchange does not wait; results are wrong by design
        if (blockIdx.x >= 64) { const long long t0_ = clock64(); while (clock64() - t0_ < 60000) __builtin_amdgcn_s_sleep(8); }
#endif
        const int row = wid * 32 + (lane & 31);
        if (lane < 32) {
            const f32x2v a = P[row * 4 + 0], b = P[row * 4 + 1], c = P[row * 4 + 2], d = P[row * 4 + 3];
            const float mt = (a.x + b.x + c.x + d.x) * 0.25f;
            const float da = a.x - mt, db = b.x - mt, dc = c.x - mt, dd = d.x - mt;
            const float m2 = (a.y + b.y) + (c.y + d.y) + 64.0f * ((da * da + db * db) + (dc * dc + dd * dd));
            unsigned long long* slot = (unsigned long long*)xbuf + ((size_t)(u.pm * BM + row) * 4 + u.pn);
            __hip_atomic_store(slot, ((unsigned long long)__float_as_uint(m2) << 32) | __float_as_uint(mt), __ATOMIC_RELAXED, __HIP_MEMORY_SCOPE_AGENT);
        }
        asm volatile("s_waitcnt vmcnt(0)" ::: "memory");
        if (lane == 0) __hip_atomic_fetch_add(cnt + 64 * u.pm, 1u, __ATOMIC_RELAXED, __HIP_MEMORY_SCOPE_AGENT);
        if (wid == 0) {
            bool dead = false; const unsigned long long t0 = __builtin_amdgcn_s_memrealtime(); const unsigned want = 8u * (unsigned)ntn;
            for (;;) {
#if defined(BROKEN_EXCHANGE_NO_WAIT)
                break;
#endif
                if ((unsigned)__builtin_amdgcn_readfirstlane(__hip_atomic_load(cnt + 64 * u.pm, __ATOMIC_RELAXED, __HIP_MEMORY_SCOPE_AGENT)) >= want) break;
                if (__builtin_amdgcn_s_memrealtime() - t0 > 2000000ull) {
                    if (lane == 0) { unsigned expect = 0u; __hip_atomic_compare_exchange_strong(tmo + 1, &expect, code | (unsigned)(u.pm & 0xff), __ATOMIC_RELAXED, __ATOMIC_RELAXED, __HIP_MEMORY_SCOPE_AGENT);
                                     __hip_atomic_store(tmo, 1u, __ATOMIC_RELAXED, __HIP_MEMORY_SCOPE_AGENT); }
                    dead = true; break; }
                __builtin_amdgcn_s_sleep(2);
            }
            __builtin_amdgcn_fence(__ATOMIC_ACQUIRE, "agent");
            if (lane == 0) flag[0] = dead ? 1u : 0u;
        }
        asm volatile("s_waitcnt vmcnt(0) lgkmcnt(0)" ::: "memory"); __builtin_amdgcn_s_barrier(); asm volatile("" ::: "memory");
        const bool bad = flag[0] != 0u;
        if (lane < 32) {
            const unsigned long long* slot = (const unsigned long long*)xbuf + (size_t)(u.pm * BM + row) * 4; float mt[4], m2[4]; float ms = 0.f;
#pragma unroll
            for (int t = 0; t < 4; ++t) { if (t < ntn) { const unsigned long long w = __hip_atomic_load(slot + t, __ATOMIC_RELAXED, __HIP_MEMORY_SCOPE_AGENT); mt[t] = __uint_as_float((unsigned)w); m2[t] = __uint_as_float((unsigned)(w >> 32)); } else { mt[t] = 0.f; m2[t] = 0.f; } ms += mt[t]; }
            const float mean = ms / (float)ntn; float q = 0.f;
#pragma unroll
            for (int t = 0; t < 4; ++t) if (t < ntn) { const float dm = mt[t] - mean; q += m2[t] + 256.0f * dm * dm; }
            S[row] = (f32x2v){mean, 1.0f / sqrtf(q / (256.0f * (float)ntn) + eps)};
        }
        asm volatile("s_waitcnt lgkmcnt(0)" ::: "memory"); __builtin_amdgcn_s_barrier(); asm volatile("" ::: "memory");
        return bad;
    }
};
struct EpiLnRes {
    static constexpr bool PERM = false, AFTER_DRAIN = true;
    const float* base; float* out; int ldc; const float* bias; PanelStats st; unsigned poison;
    __device__ __forceinline__ void fused(f32x4 (&acc)[2][2][4][2], const Unit& u, int wr, int wc, int fr, int fq, PG8_LAS unsigned char* lds, int wid, int lane) const {
        typedef float f32x2v __attribute__((ext_vector_type(2)));
        const PG8_LAS f32x2v* S = (const PG8_LAS f32x2v*)(lds + 8192);
        const int col0 = u.pn * BM + wc * 32 + 4 * fq;
#pragma unroll
        for (int bj = 0; bj < 2; ++bj)
#pragma unroll
            for (int n = 0; n < 2; ++n) { const f32x4 bv = bias ? *(const f32x4*)(bias + col0 + bj * HALF + n * 16) : (f32x4){0.f, 0.f, 0.f, 0.f};
#pragma unroll
                for (int ai = 0; ai < 2; ++ai)
#pragma unroll
                    for (int m = 0; m < 4; ++m) acc[ai][bj][m][n] += bv; }
        f32x4 pre[4][2][2];
#pragma unroll
        for (int m = 0; m < 4; ++m) { const size_t off = (size_t)(u.pm * BM + wr * 64 + m * 16 + fr) * ldc + col0;
#pragma unroll
            for (int bj = 0; bj < 2; ++bj)
#pragma unroll
                for (int n = 0; n < 2; ++n) pre[m][bj][n] = *(const f32x4*)(base + off + bj * HALF + n * 16); }
        const bool bad = st.run(acc, u, wr, wc, fr, fq, lds, wid, lane) || poison != 0u;
        const float qnan = __builtin_nanf("");
#pragma unroll
        for (int ai = 0; ai < 2; ++ai)
#pragma unroll
            for (int m = 0; m < 4; ++m) { const int r = ai * HALF + wr * 64 + m * 16 + fr; const f32x2v sr = S[r]; const size_t off = (size_t)(u.pm * BM + r) * ldc + col0;
#pragma unroll
                for (int bj = 0; bj < 2; ++bj)
#pragma unroll
                    for (int n = 0; n < 2; ++n) { const f32x4 bs = ai == 0 ? pre[m][bj][n] : *(const f32x4*)(base + off + bj * HALF + n * 16); f32x4 o = bs + (acc[ai][bj][m][n] - sr.x) * sr.y;
                        if (bad) o = (f32x4){qnan, qnan, qnan, qnan}; *(f32x4*)(out + off + bj * HALF + n * 16) = o; }
                if (m & 1) asm volatile("" ::: "memory"); }
    }
};
struct EpiLnResLn {
    static constexpr bool PERM = false, AFTER_DRAIN = true;
    const float* base; float* out; bf16_t* xn; int ldc; const float* bias; PanelStats st1, st2; unsigned poison;
    __device__ __forceinline__ void fused(f32x4 (&acc)[2][2][4][2], const Unit& u, int wr, int wc, int fr, int fq, PG8_LAS unsigned char* lds, int wid, int lane) const {
        typedef float f32x2v __attribute__((ext_vector_type(2))); typedef unsigned u32x2v __attribute__((ext_vector_type(2)));
        const PG8_LAS f32x2v* S = (const PG8_LAS f32x2v*)(lds + 8192);
        const int col0 = u.pn * BM + wc * 32 + 4 * fq;
#pragma unroll
        for (int bj = 0; bj < 2; ++bj)
#pragma unroll
            for (int n = 0; n < 2; ++n) { const f32x4 bv = bias ? *(const f32x4*)(bias + col0 + bj * HALF + n * 16) : (f32x4){0.f, 0.f, 0.f, 0.f};
#pragma unroll
                for (int ai = 0; ai < 2; ++ai)
#pragma unroll
                    for (int m = 0; m < 4; ++m) acc[ai][bj][m][n] += bv; }
        bool bad = st1.run(acc, u, wr, wc, fr, fq, lds, wid, lane) || poison != 0u;
        const float qnan = __builtin_nanf("");
#pragma unroll
        for (int ai = 0; ai < 2; ++ai)
#pragma unroll
            for (int m = 0; m < 4; ++m) { const int r = ai * HALF + wr * 64 + m * 16 + fr; const f32x2v sr = S[r]; const size_t off = (size_t)(u.pm * BM + r) * ldc + col0;
#pragma unroll
                for (int bj = 0; bj < 2; ++bj)
#pragma unroll
                    for (int n = 0; n < 2; ++n) { const f32x4 bs = *(const f32x4*)(base + off + bj * HALF + n * 16); acc[ai][bj][m][n] = bs + (acc[ai][bj][m][n] - sr.x) * sr.y; }
                asm volatile("" : "+v"(acc[ai][0][m][0]), "+v"(acc[ai][0][m][1]), "+v"(acc[ai][1][m][0]), "+v"(acc[ai][1][m][1]));
                if (m & 1) asm volatile("" ::: "memory"); }
        const bool bad1 = bad;
        bad = st2.run(acc, u, wr, wc, fr, fq, lds, wid, lane) || bad;
#pragma unroll
        for (int ai = 0; ai < 2; ++ai)
#pragma unroll
            for (int m = 0; m < 4; ++m) { const int r = ai * HALF + wr * 64 + m * 16 + fr; const f32x2v sr = S[r]; const size_t off = (size_t)(u.pm * BM + r) * ldc + col0;
#pragma unroll
                for (int bj = 0; bj < 2; ++bj)
#pragma unroll
                    for (int n = 0; n < 2; ++n) { const f32x4 x1 = acc[ai][bj][m][n]; *(f32x4*)(out + off + bj * HALF + n * 16) = bad1 ? (f32x4){qnan, qnan, qnan, qnan} : x1;
                        const f32x4 o = (x1 - sr.x) * sr.y; u32x2v w; w.x = cvt_pk_bf16(o[0], o[1]); w.y = cvt_pk_bf16(o[2], o[3]);
                        if (bad) { w.x = 0x7fc07fc0u; w.y = 0x7fc07fc0u; } *(u32x2v*)(xn + off + bj * HALF + n * 16) = w; }
                asm volatile("" ::: "memory"); }
    }
};

template <class Epi, class Sched, bool ALIGN_EPI = false, bool SP2 = false>
__device__ __forceinline__ void gemm_phase(PG8_LAS unsigned char* lds, const Gemm g, const Sched& S, const Epi& E) {
    const int tid = threadIdx.x, wid = __builtin_amdgcn_readfirstlane(tid >> 6), lane = tid & 63, wr = wid >> 2, wc = wid & 3, fr = lane & 15, fq = lane >> 4;
    const int K = g.K, nt = K / BK;
    unsigned voffA[2], voffB[2];
#pragma unroll
    for (int i = 0; i < 2; ++i) { int R, C; stage_rc(tid * 16 + i * 8192, R, C); const int Rb = Epi::PERM ? ((R & ~31) + perm32(R & 31)) : R;
        voffA[i] = (unsigned)(R * K + C) * 2u; voffB[i] = (unsigned)(Rb * K + C) * 2u; }
    const size_t kstep = (size_t)(BK * 2);
    const size_t hstep = (size_t)HALF * K * 2;
    const size_t tstep = 2 * hstep;
    const unsigned ldsw = (unsigned)wid * 1024u;
    const int aoff = lds_byte(wr * 64 + fr, fq * 8), boff = lds_byte(wc * 32 + fr, fq * 8);
#define PG8_SA(b, h) (((b) * 2 + (h)) * HTB)
#define PG8_SB(b, h) ((4 + (b) * 2 + (h)) * HTB)
#define PG8_STAGE(bufoff, gbase, voff) do { _Pragma("unroll") for (int _i = 0; _i < 2; ++_i) \
        __builtin_amdgcn_global_load_lds((const unsigned*)((const char*)(gbase) + (voff)[_i]), (PG8_LAS unsigned*)(lds + (bufoff) + ldsw + _i * 8192), 16, 0, 0); } while (0)
#define PG8_LDA(dst, b, h) do { _Pragma("unroll") for (int m = 0; m < 4; ++m) _Pragma("unroll") for (int k = 0; k < 2; ++k) dst[m][k] = *(const PG8_LAS bf16x8*)(lds + PG8_SA(b, h) + aoff + m * 2048 + k * 1024); } while (0)
#define PG8_LDB(dst, b, h) do { _Pragma("unroll") for (int n = 0; n < 2; ++n) _Pragma("unroll") for (int k = 0; k < 2; ++k) dst[n][k] = *(const PG8_LAS bf16x8*)(lds + PG8_SB(b, h) + boff + n * 2048 + k * 1024); } while (0)
#define PG8_MMA(ai, bj, At, Bt) do { __builtin_amdgcn_s_setprio(1); _Pragma("unroll") for (int m = 0; m < 4; ++m) _Pragma("unroll") for (int n = 0; n < 2; ++n) _Pragma("unroll") for (int k = 0; k < 2; ++k) \
        acc[ai][bj][m][n] = __builtin_amdgcn_mfma_f32_16x16x32_bf16(Bt[n][k], At[m][k], acc[ai][bj][m][n], 0, 0, 0); __builtin_amdgcn_s_setprio(0); } while (0)
#define PG8_WAIT_V(n) asm volatile("s_waitcnt vmcnt(" #n ")" ::: "memory")
#define PG8_WAIT_L(n) asm volatile("s_waitcnt lgkmcnt(" #n ")" ::: "memory")
#define PG8_BAR __builtin_amdgcn_s_barrier()
#define PG8_SCHED __builtin_amdgcn_sched_barrier(0)
    Unit cur, nxt; int ui = 0;
    if (!S.next(0, cur)) return;
    f32x4 acc[2][2][4][2];
#pragma unroll
    for (int a = 0; a < 2; ++a)
#pragma unroll
        for (int b = 0; b < 2; ++b)
#pragma unroll
            for (int m = 0; m < 4; ++m)
#pragma unroll
                for (int n = 0; n < 2; ++n) acc[a][b][m][n] = (f32x4){0.f, 0.f, 0.f, 0.f};
    bf16x8 At[4][2], B0[2][2], B1[2][2];
    const char* cA = (const char*)g.A + (size_t)cur.pm * tstep; const char* cB = (const char*)g.Bt + (size_t)cur.pn * tstep;
    S.a_ready(cur);
    if constexpr (SP2) {
        PG8_STAGE(PG8_SB(0, 0), cB, voffB); PG8_STAGE(PG8_SB(0, 1), cB + hstep, voffB); PG8_STAGE(PG8_SA(0, 0), cA, voffA); PG8_STAGE(PG8_SA(0, 1), cA + hstep, voffA);
        if (wr == 1) PG8_BAR;
        PG8_WAIT_V(2); PG8_BAR;
        PG8_STAGE(PG8_SB(1, 0), cB + kstep, voffB); PG8_STAGE(PG8_SA(1, 0), cA + kstep, voffA); PG8_STAGE(PG8_SB(1, 1), cB + hstep + kstep, voffB);
        PG8_WAIT_V(6); PG8_BAR;
    } else {
        PG8_STAGE(PG8_SB(0, 0), cB, voffB); PG8_STAGE(PG8_SA(0, 0), cA, voffA); PG8_STAGE(PG8_SB(0, 1), cB + hstep, voffB); PG8_STAGE(PG8_SA(0, 1), cA + hstep, voffA);
        if (wr == 1) PG8_BAR;
        PG8_WAIT_V(4); PG8_BAR;
        PG8_STAGE(PG8_SB(1, 0), cB + kstep, voffB); PG8_STAGE(PG8_SA(1, 0), cA + kstep, voffA); PG8_STAGE(PG8_SB(1, 1), cB + hstep + kstep, voffB);
        PG8_WAIT_V(6); PG8_BAR;
    }
    for (;;) {
        const bool has_next = S.next(ui + 1, nxt);
        const char* nA = has_next ? (const char*)g.A + (size_t)nxt.pm * tstep : cA; const char* nB = has_next ? (const char*)g.Bt + (size_t)nxt.pn * tstep : cB;
        for (int t = 0; t < nt; t += 2) {
            const bool last = (t == nt - 2);
            const char* a1 = cA + (size_t)(t + 1) * kstep;
            const char* a2 = last ? nA : cA + (size_t)(t + 2) * kstep; const char* b2 = last ? nB : cB + (size_t)(t + 2) * kstep;
            const char* a3 = a2 + kstep; const char* b3 = b2 + kstep;
            if (last && has_next) S.a_ready(nxt);
            if constexpr (SP2) {
            PG8_LDB(B0, 0, 0); PG8_LDB(B1, 0, 1); PG8_SCHED; PG8_LDA(At, 0, 0); PG8_STAGE(PG8_SA(1, 1), a1 + hstep, voffA);
            PG8_WAIT_V(8); PG8_WAIT_L(0); PG8_BAR; PG8_MMA(0, 0, At, B0); PG8_MMA(0, 1, At, B1); PG8_BAR; PG8_SCHED;
            PG8_LDA(At, 0, 1); PG8_STAGE(PG8_SB(0, 0), b2, voffB); PG8_STAGE(PG8_SB(0, 1), b2 + hstep, voffB); PG8_STAGE(PG8_SA(0, 0), a2, voffA);
            PG8_WAIT_V(8); PG8_WAIT_L(0); PG8_BAR; PG8_MMA(1, 0, At, B0); PG8_MMA(1, 1, At, B1); PG8_BAR; PG8_SCHED;
            PG8_LDB(B0, 1, 0); PG8_LDB(B1, 1, 1); PG8_SCHED; PG8_LDA(At, 1, 0); PG8_STAGE(PG8_SA(0, 1), a2 + hstep, voffA);
            PG8_WAIT_V(8); PG8_WAIT_L(0); PG8_BAR; PG8_MMA(0, 0, At, B0); PG8_MMA(0, 1, At, B1); PG8_BAR; PG8_SCHED;
            PG8_LDA(At, 1, 1); PG8_STAGE(PG8_SB(1, 0), b3, voffB); PG8_STAGE(PG8_SB(1, 1), b3 + hstep, voffB); PG8_STAGE(PG8_SA(1, 0), a3, voffA);
            PG8_WAIT_V(8); PG8_WAIT_L(0); PG8_BAR; PG8_MMA(1, 0, At, B0); PG8_MMA(1, 1, At, B1); PG8_BAR; PG8_SCHED;
            } else {
            PG8_LDB(B0, 0, 0); PG8_SCHED; PG8_LDA(At, 0, 0); PG8_STAGE(PG8_SA(1, 1), a1 + hstep, voffA);
            PG8_WAIT_L(8); PG8_BAR; PG8_WAIT_L(0); PG8_MMA(0, 0, At, B0); PG8_BAR; PG8_SCHED;
            PG8_LDB(B1, 0, 1); PG8_STAGE(PG8_SB(0, 0), b2, voffB);
            PG8_BAR; PG8_WAIT_L(0); PG8_MMA(0, 1, At, B1); PG8_BAR;
            PG8_LDA(At, 0, 1); PG8_STAGE(PG8_SA(0, 0), a2, voffA);
            PG8_BAR; PG8_WAIT_L(0); PG8_MMA(1, 0, At, B0); PG8_BAR; PG8_SCHED;
            PG8_STAGE(PG8_SB(0, 1), b2 + hstep, voffB);
            PG8_WAIT_V(6); PG8_BAR; PG8_MMA(1, 1, At, B1); PG8_BAR;
            PG8_LDB(B0, 1, 0); PG8_SCHED; PG8_LDA(At, 1, 0); PG8_STAGE(PG8_SA(0, 1), a2 + hstep, voffA);
            PG8_WAIT_L(8); PG8_BAR; PG8_WAIT_L(0); PG8_MMA(0, 0, At, B0); PG8_BAR; PG8_SCHED;
            PG8_LDB(B1, 1, 1); PG8_STAGE(PG8_SB(1, 0), b3, voffB);
            PG8_BAR; PG8_WAIT_L(0); PG8_MMA(0, 1, At, B1); PG8_BAR;
            PG8_LDA(At, 1, 1); PG8_STAGE(PG8_SA(1, 0), a3, voffA);
            PG8_BAR; PG8_WAIT_L(0); PG8_MMA(1, 0, At, B0); PG8_BAR; PG8_SCHED;
            PG8_STAGE(PG8_SB(1, 1), b3 + hstep, voffB);
            PG8_WAIT_V(6); PG8_BAR; PG8_MMA(1, 1, At, B1); PG8_BAR;
            }
        }
        if constexpr (ALIGN_EPI) { if (wr == 0) PG8_BAR; }
        if constexpr (!Epi::AFTER_DRAIN) { E(acc, cur, wr, wc, fr, fq); S.done(cur); }
        if (!has_next) break;
#pragma unroll
        for (int a = 0; a < 2; ++a)
#pragma unroll
            for (int b = 0; b < 2; ++b)
#pragma unroll
                for (int m = 0; m < 4; ++m)
#pragma unroll
                    for (int n = 0; n < 2; ++n) acc[a][b][m][n] = (f32x4){0.f, 0.f, 0.f, 0.f};
        cur = nxt; cA = nA; cB = nB; ++ui;
        if constexpr (ALIGN_EPI) { if (wr == 1) PG8_BAR; }
    }
    PG8_WAIT_V(0);
    if constexpr (!ALIGN_EPI) { if (wr == 0) PG8_BAR; }
    PG8_BAR;
    if constexpr (Epi::AFTER_DRAIN) { E.fused(acc, cur, wr, wc, fr, fq, lds, wid, lane); S.done(cur); }
#undef PG8_SA
#undef PG8_SB
#undef PG8_STAGE
#undef PG8_LDA
#undef PG8_LDB
#undef PG8_MMA
#undef PG8_WAIT_V
#undef PG8_WAIT_L
#undef PG8_BAR
#undef PG8_SCHED
}
}

namespace pg8 {
typedef unsigned u32x2 __attribute__((ext_vector_type(2)));
__device__ __forceinline__ float bflo(unsigned w) { return __uint_as_float(w << 16); }
__device__ __forceinline__ float bfhi(unsigned w) { return __uint_as_float(w & 0xffff0000u); }
__device__ __forceinline__ float silu_f(float x) { return x * __builtin_amdgcn_rcpf(1.0f + __expf(-x)); }
__device__ __forceinline__ float sigm_f(float x) { return __builtin_amdgcn_rcpf(1.0f + __expf(-x)); }

struct EpiSwiglu {
    static constexpr bool PERM = true, AFTER_DRAIN = false;
    bf16_t* O; int ldc;
    __device__ __forceinline__ void operator()(const f32x4 (&acc)[2][2][4][2], const Unit& u, int wr, int wc, int fr, int fq) const {
        const int row0 = u.pm * BM + wr * 64 + fr, col0 = u.pn * HALF + wc * 32 + 8 * fq;
#pragma unroll
        for (int ai = 0; ai < 2; ++ai)
#pragma unroll
            for (int m = 0; m < 4; ++m) {
                bf16_t* rowp = O + (size_t)(row0 + ai * HALF + m * 16) * ldc + col0;
                const f32x4 g0 = acc[ai][0][m][0], g1 = acc[ai][0][m][1], u0 = acc[ai][1][m][0], u1 = acc[ai][1][m][1];
                u32x4 w;
                w.x = cvt_pk_bf16(silu_f(g0[0]) * u0[0], silu_f(g0[1]) * u0[1]); w.y = cvt_pk_bf16(silu_f(g0[2]) * u0[2], silu_f(g0[3]) * u0[3]);
                w.z = cvt_pk_bf16(silu_f(g1[0]) * u1[0], silu_f(g1[1]) * u1[1]); w.w = cvt_pk_bf16(silu_f(g1[2]) * u1[2], silu_f(g1[3]) * u1[3]);
                *(u32x4*)rowp = w;
            }
    }
};
struct EpiPlain {
    static constexpr bool PERM = true, AFTER_DRAIN = false;
    bf16_t* O; int ldc;
    __device__ __forceinline__ void operator()(const f32x4 (&acc)[2][2][4][2], const Unit& u, int wr, int wc, int fr, int fq) const {
        const int row0 = u.pm * BM + wr * 64 + fr, col0 = u.pn * BM + wc * 32 + 8 * fq;
#pragma unroll
        for (int ai = 0; ai < 2; ++ai)
#pragma unroll
            for (int m = 0; m < 4; ++m) {
                bf16_t* rowp = O + (size_t)(row0 + ai * HALF + m * 16) * ldc + col0;
#pragma unroll
                for (int bj = 0; bj < 2; ++bj) { const f32x4 v0 = acc[ai][bj][m][0], v1 = acc[ai][bj][m][1]; u32x4 w;
                    w.x = cvt_pk_bf16(v0[0], v0[1]); w.y = cvt_pk_bf16(v0[2], v0[3]); w.z = cvt_pk_bf16(v1[0], v1[1]); w.w = cvt_pk_bf16(v1[2], v1[3]);
                    *(u32x4*)(rowp + bj * HALF) = w; }
            }
    }
};
struct EpiWin {
    static constexpr bool PERM = true, AFTER_DRAIN = false;
    bf16_t* Z; const float2* rope;
    __device__ __forceinline__ void operator()(const f32x4 (&acc)[2][2][4][2], const Unit& u, int wr, int wc, int fr, int fq) const {
        const int row0 = u.pm * BM + wr * 64 + fr, col0 = u.pn * BM + wc * 32 + 8 * fq;
#pragma unroll
        for (int ai = 0; ai < 2; ++ai)
#pragma unroll
            for (int m = 0; m < 4; ++m) {
                const int row = row0 + ai * HALF + m * 16;
                const int pidx = row < 32768 ? (row & 8191) : 8192 + ((row - 32768) & 3);
                bf16_t* rowp = Z + (size_t)row * 1280 + col0;
#pragma unroll
                for (int bj = 0; bj < 2; ++bj) {
                    f32x4 v[2] = {acc[ai][bj][m][0], acc[ai][bj][m][1]};
                    const bool dorope = ((u.pn == 2) || (u.pn == 3) || (u.pn == 4 && bj == 0)) && ((wc & 1) == 0);
                    if (dorope) {
#pragma unroll
                        for (int n = 0; n < 2; ++n)
#pragma unroll
                            for (int e = 0; e < 4; ++e) {
                                const float x = v[n][e]; const float p = __shfl_xor(x, 16);
                                const float2 cs = rope[pidx * 8 + 4 * n + e];
                                const float r0 = x * cs.x - p * cs.y, r1 = x * cs.x + p * cs.y;
                                v[n][e] = fq == 0 ? r0 : (fq == 1 ? r1 : x);
                            }
                    }
                    u32x4 w; w.x = cvt_pk_bf16(v[0][0], v[0][1]); w.y = cvt_pk_bf16(v[0][2], v[0][3]); w.z = cvt_pk_bf16(v[1][0], v[1][1]); w.w = cvt_pk_bf16(v[1][2], v[1][3]);
                    *(u32x4*)(rowp + bj * HALF) = w;
                }
            }
    }
};
struct EpiGlu {
    static constexpr bool PERM = true, AFTER_DRAIN = false;
    const bf16_t* G; const float* bias; bf16_t* O; int ldo;
    __device__ __forceinline__ void operator()(const f32x4 (&acc)[2][2][4][2], const Unit& u, int wr, int wc, int fr, int fq) const {
        const int row0 = u.pm * BM + wr * 64 + fr, col0 = u.pn * BM + wc * 32 + 8 * fq;
#pragma unroll
        for (int ai = 0; ai < 2; ++ai)
#pragma unroll
            for (int m = 0; m < 4; ++m) {
                const int row = row0 + ai * HALF + m * 16;
#pragma unroll
                for (int bj = 0; bj < 2; ++bj) {
                    const int col = col0 + bj * HALF;
                    const u32x4 gv = *(const u32x4*)(G + (size_t)row * 512 + col);
                    const f32x4 b0 = *(const f32x4*)(bias + col), b1 = *(const f32x4*)(bias + col + 4);
                    const f32x4 v0 = acc[ai][bj][m][0] + b0, v1 = acc[ai][bj][m][1] + b1;
                    u32x4 w;
                    w.x = cvt_pk_bf16(bflo(gv.x) * sigm_f(v0[0]), bfhi(gv.x) * sigm_f(v0[1])); w.y = cvt_pk_bf16(bflo(gv.y) * sigm_f(v0[2]), bfhi(gv.y) * sigm_f(v0[3]));
                    w.z = cvt_pk_bf16(bflo(gv.z) * sigm_f(v1[0]), bfhi(gv.z) * sigm_f(v1[1])); w.w = cvt_pk_bf16(bflo(gv.w) * sigm_f(v1[2]), bfhi(gv.w) * sigm_f(v1[3]));
                    *(u32x4*)(O + (size_t)row * ldo + col) = w;
                }
            }
    }
};
struct EpiMemKV {
    static constexpr bool PERM = true, AFTER_DRAIN = false;
    float* OKp; float* OVp; bf16_t* MK; bf16_t* MVT;
    __device__ __forceinline__ void operator()(const f32x4 (&acc)[2][2][4][2], const Unit& u, int wr, int wc, int fr, int fq) const {
        const int row0 = u.pm * BM + wr * 64 + fr, col0 = u.pn * BM + wc * 32 + 8 * fq;
#pragma unroll
        for (int ai = 0; ai < 2; ++ai)
#pragma unroll
            for (int m = 0; m < 4; ++m) {
                const int row = row0 + ai * HALF + m * 16;
#pragma unroll
                for (int bj = 0; bj < 2; ++bj) {
                    const int col = col0 + bj * HALF;
                    const f32x4 v0 = acc[ai][bj][m][0], v1 = acc[ai][bj][m][1];
                    if (u.pn < 4) {
                        *(f32x4*)(OKp + (size_t)row * 1024 + col) = v0; *(f32x4*)(OKp + (size_t)row * 1024 + col + 4) = v1;
                        u32x4 w; w.x = cvt_pk_bf16(v0[0], v0[1]); w.y = cvt_pk_bf16(v0[2], v0[3]); w.z = cvt_pk_bf16(v1[0], v1[1]); w.w = cvt_pk_bf16(v1[2], v1[3]);
                        *(u32x4*)(MK + (size_t)row * 1024 + col) = w;
                    } else {
                        const int cv = col - 1024;
                        *(f32x4*)(OVp + (size_t)row * 1024 + cv) = v0; *(f32x4*)(OVp + (size_t)row * 1024 + cv + 4) = v1;
                        const int b = row >> 8, mt = row & 255;
                        bf16_t* vt = MVT + ((size_t)(b * 1024 + cv) * 256 + mt);
                        const unsigned w0 = cvt_pk_bf16(v0[0], v0[1]), w1 = cvt_pk_bf16(v0[2], v0[3]), w2 = cvt_pk_bf16(v1[0], v1[1]), w3 = cvt_pk_bf16(v1[2], v1[3]);
                        vt[0 * 256] = (bf16_t)w0; vt[1 * 256] = (bf16_t)(w0 >> 16); vt[2 * 256] = (bf16_t)w1; vt[3 * 256] = (bf16_t)(w1 >> 16);
                        vt[4 * 256] = (bf16_t)w2; vt[5 * 256] = (bf16_t)(w2 >> 16); vt[6 * 256] = (bf16_t)w3; vt[7 * 256] = (bf16_t)(w3 >> 16);
                    }
                }
            }
    }
};
}

#include <hip/hip_cooperative_groups.h>
namespace cg = cooperative_groups;

#define LAS __attribute__((address_space(3)))
typedef unsigned short bf16;
typedef unsigned v4u __attribute__((ext_vector_type(4)));
typedef unsigned v2u __attribute__((ext_vector_type(2)));
typedef float f32x4 __attribute__((ext_vector_type(4)));
typedef float f32x16 __attribute__((ext_vector_type(16)));
typedef short bf16x8 __attribute__((ext_vector_type(8)));
typedef short s16x4 __attribute__((ext_vector_type(4)));

constexpr int NWAVES = 8, NTHR = 512;
constexpr int D = 1024, FF = 2816, NPROW = 32768, NSROW = 512, M = NPROW + NSROW, SEQ = 8192, NB = 4, DB = 128, INW = 1280;
constexpr float EPS = 1e-6f;
constexpr size_t MiB = 1u << 20;
constexpr size_t WS_ROPE = 1 * MiB, WS_SSM = 2 * MiB, WS_MN = 3 * MiB;
constexpr size_t WS_W1GU = 5 * MiB, WS_W1D = 16 * MiB, WS_W2GU = 22 * MiB, WS_W2D = 33 * MiB, WS_WIN = 39 * MiB, WS_WGLU = 42 * MiB, WS_WOUT = 43 * MiB, WS_WMQ = 45 * MiB, WS_WMKV = 47 * MiB, WS_WMO = 51 * MiB;
constexpr size_t WS_XN = 56 * MiB, WS_CB = 121 * MiB, WS_ACT = 186 * MiB;
constexpr size_t WS_Z = 186 * MiB, WS_G = 268 * MiB, WS_E = 301 * MiB, WS_Q2 = 186 * MiB, WS_O2 = 252 * MiB;
constexpr size_t WS_MK = 365 * MiB, WS_MVT = 367 * MiB, WS_END = 369 * MiB;
constexpr size_t SSM_LAMT = 0, SSM_BBF = 128 * 1024, SSM_CMF = 256 * 1024;
constexpr size_t O_PSRE = (size_t)M * D, O_PSIM = O_PSRE + 8192, O_PWK = O_PSIM + 8192, O_PWV = O_PWK + 65536, O_PMK = O_PWV + 65536, O_PMV = O_PMK + 1048576,
                 O_SSRE = O_PMV + 1048576, O_SSIM = O_SSRE + 262144, O_SWK = O_SSIM + 262144, O_SWV = O_SWK + 2097152, O_END = O_SWV + 2097152;
constexpr int LDS_BYTES = 147456;

struct Args { const float* in[43]; float* out; unsigned char* ws; int ph_lo, ph_hi; };

__device__ __forceinline__ unsigned f2bf(float f) { unsigned u = __builtin_bit_cast(unsigned, f); return (u + 0x7fffu + ((u >> 16) & 1u)) >> 16; }
__device__ __forceinline__ unsigned pk2(float lo, float hi) { return pg8::cvt_pk_bf16(lo, hi); }
__device__ __forceinline__ float bf2f(bf16 b) { return __uint_as_float((unsigned)b << 16); }
__device__ __forceinline__ float wave_sum(float v) {
#pragma unroll
    for (int o = 1; o < 64; o <<= 1) v += __shfl_xor(v, o);
    return v;
}
__device__ __forceinline__ float wave_max(float v) {
#pragma unroll
    for (int o = 1; o < 64; o <<= 1) v = fmaxf(v, __shfl_xor(v, o));
    return v;
}
__device__ __forceinline__ void dsincos(double x, double& s, double& c) {
    const double k = rint(x * 0.63661977236758134308);
    double r = fma(-k, 1.57079632679489655800e+00, x); r = fma(-k, 6.12323399573676603587e-17, r);
    const long long q = (long long)k; const double r2 = r * r;
    double sp = -1.0 / 1307674368000.0; sp = fma(sp, r2, 1.0 / 6227020800.0); sp = fma(sp, r2, -1.0 / 39916800.0); sp = fma(sp, r2, 1.0 / 362880.0); sp = fma(sp, r2, -1.0 / 5040.0);
    sp = fma(sp, r2, 1.0 / 120.0); sp = fma(sp, r2, -1.0 / 6.0); sp = fma(sp * r2, r, r);
    double cp = 1.0 / 20922789888000.0; cp = fma(cp, r2, -1.0 / 87178291200.0); cp = fma(cp, r2, 1.0 / 479001600.0); cp = fma(cp, r2, -1.0 / 3628800.0); cp = fma(cp, r2, 1.0 / 40320.0);
    cp = fma(cp, r2, -1.0 / 720.0); cp = fma(cp, r2, 1.0 / 24.0); cp = fma(cp, r2, -0.5); cp = fma(cp, r2, 1.0);
    const int qq = (int)(q & 3);
    s = (qq == 0) ? sp : (qq == 1) ? cp : (qq == 2) ? -sp : -cp;
    c = (qq == 0) ? cp : (qq == 1) ? -sp : (qq == 2) ? -cp : sp;
}
__device__ __forceinline__ double dexp(double x) {
    const double k = rint(x * 1.4426950408889634074);
    double r = fma(-k, 6.93147180369123816490e-01, x); r = fma(-k, 1.90821492927058770002e-10, r);
    double p = 1.0;
#pragma unroll
    for (int i = 14; i >= 1; --i) p = fma(p, r * (1.0 / (double)i), 1.0);
    const long long e = (long long)k + 1023;
    return p * __longlong_as_double((long long)((unsigned long long)e << 52));
}

struct Frame {
    LAS unsigned char* lds;
    int tid, lane, wave, G;
    const float* const* in; float* out; unsigned char* ws;
};
#define INP(k) (F.in[k])
__device__ __forceinline__ const float* xrow_ptr(const Frame& F, int row) { return row < NPROW ? INP(0) + (size_t)row * D : INP(1) + (size_t)(row - NPROW) * D; }

__device__ __forceinline__ void p0_transpose_item(const float* W, int K, int N, bf16* WT, int row_off, int mode, LAS float* scr, int item, int lane) {
    const int nblk = N / 32, kb = item / nblk, nb = item % nblk, k0 = 64 * kb, n0 = 32 * nb;
    const int drow0 = mode == 0 ? row_off + n0 : (256 * (n0 >> 7) + (n0 & 127) + (mode == 2 ? 128 : 0));
#pragma unroll 8
    for (int i = 0; i < 32; ++i) { const int kk = 2 * i + (lane >> 5); scr[kk * 33 + (lane & 31)] = W[(size_t)(k0 + kk) * N + n0 + (lane & 31)]; }
    asm volatile("s_waitcnt lgkmcnt(0)" ::: "memory");
    const int c = lane & 7;
#pragma unroll
    for (int j = 0; j < 4; ++j) { const int n = (lane >> 3) + 8 * j; const LAS float* s = scr + (8 * c) * 33 + n;
        v4u o; o.x = pk2(s[0 * 33], s[1 * 33]); o.y = pk2(s[2 * 33], s[3 * 33]); o.z = pk2(s[4 * 33], s[5 * 33]); o.w = pk2(s[6 * 33], s[7 * 33]);
        *(v4u*)(WT + (size_t)(drow0 + n) * K + k0 + 8 * c) = o; }
    asm volatile("s_waitcnt lgkmcnt(0)" ::: "memory");
}
__device__ __forceinline__ void rms_row_to_bf16(const Frame& F, const float* xrow, const float* g, bf16* orow) {
    const f32x4* xr = (const f32x4*)xrow + F.lane; const f32x4* gr = (const f32x4*)g + F.lane;
    f32x4 v[4]; float s = 0.f;
#pragma unroll
    for (int j = 0; j < 4; ++j) { v[j] = xr[64 * j]; s += (v[j].x * v[j].x + v[j].y * v[j].y) + (v[j].z * v[j].z + v[j].w * v[j].w); }
    const float r = 1.0f / sqrtf(wave_sum(s) * (1.f / D) + EPS);
    v2u* o8 = (v2u*)orow + F.lane;
#pragma unroll
    for (int j = 0; j < 4; ++j) { const f32x4 gg = gr[64 * j]; v2u w; w.x = pk2(v[j].x * r * gg.x, v[j].y * r * gg.y); w.y = pk2(v[j].z * r * gg.z, v[j].w * r * gg.w); o8[64 * j] = w; }
}
__device__ __forceinline__ void p0_prologue(const Frame& F) {
    LAS float* scr = (LAS float*)(F.lds + F.wave * 16384);
    const int gw = blockIdx.x * NWAVES + F.wave, NGW = F.G * NWAVES;
    bf16* const ws16 = (bf16*)F.ws;
    constexpr int I_GU = (D / 64) * (FF / 32), I_DN = (FF / 64) * (D / 32), I_IN = (D / 64) * (INW / 32), I_GL = (512 / 64) * (512 / 32), I_SQ = (D / 64) * (D / 32);
    constexpr int NITEMS = 4 * I_GU + 2 * I_DN + I_IN + I_GL + 5 * I_SQ;
    for (int it = gw; it < NITEMS; it += NGW) {
        int r = it;
        if (r < I_GU) { p0_transpose_item(INP(10), D, FF, (bf16*)(F.ws + WS_W1GU), 0, 1, scr, r, F.lane); continue; } r -= I_GU;
        if (r < I_GU) { p0_transpose_item(INP(11), D, FF, (bf16*)(F.ws + WS_W1GU), 0, 2, scr, r, F.lane); continue; } r -= I_GU;
        if (r < I_DN) { p0_transpose_item(INP(12), FF, D, (bf16*)(F.ws + WS_W1D), 0, 0, scr, r, F.lane); continue; } r -= I_DN;
        if (r < I_GU) { p0_transpose_item(INP(39), D, FF, (bf16*)(F.ws + WS_W2GU), 0, 1, scr, r, F.lane); continue; } r -= I_GU;
        if (r < I_GU) { p0_transpose_item(INP(40), D, FF, (bf16*)(F.ws + WS_W2GU), 0, 2, scr, r, F.lane); continue; } r -= I_GU;
        if (r < I_DN) { p0_transpose_item(INP(41), FF, D, (bf16*)(F.ws + WS_W2D), 0, 0, scr, r, F.lane); continue; } r -= I_DN;
        if (r < I_IN) { p0_transpose_item(INP(15), D, INW, (bf16*)(F.ws + WS_WIN), 0, 0, scr, r, F.lane); continue; } r -= I_IN;
        if (r < I_GL) { p0_transpose_item(INP(24), 512, 512, (bf16*)(F.ws + WS_WGLU), 0, 0, scr, r, F.lane); continue; } r -= I_GL;
        if (r < I_SQ) { p0_transpose_item(INP(29), D, D, (bf16*)(F.ws + WS_WOUT), 0, 0, scr, r, F.lane); continue; } r -= I_SQ;
        if (r < I_SQ) { p0_transpose_item(INP(32), D, D, (bf16*)(F.ws + WS_WMQ), 0, 0, scr, r, F.lane); continue; } r -= I_SQ;
        if (r < I_SQ) { p0_transpose_item(INP(33), D, D, (bf16*)(F.ws + WS_WMKV), 0, 0, scr, r, F.lane); continue; } r -= I_SQ;
        if (r < I_SQ) { p0_transpose_item(INP(34), D, D, (bf16*)(F.ws + WS_WMKV), 1024, 0, scr, r, F.lane); continue; } r -= I_SQ;
        p0_transpose_item(INP(35), D, D, (bf16*)(F.ws + WS_WMO), 0, 0, scr, r, F.lane);
    }
    (void)ws16;
    for (int m = gw; m < M + 1024; m += NGW) {
        if (m < M) rms_row_to_bf16(F, xrow_ptr(F, m), INP(9), (bf16*)(F.ws + WS_XN) + (size_t)m * D);
        else rms_row_to_bf16(F, INP(8) + (size_t)(m - M) * D, INP(31), (bf16*)(F.ws + WS_MN) + (size_t)(m - M) * D);
    }
    const int gt = blockIdx.x * NTHR + F.tid, NGT = F.G * NTHR;
    for (int i = gt; i < 8196 * 8; i += NGT) {
        const int pi = i >> 3, fi = i & 7; const double pos = pi < 8192 ? (double)pi : (double)(16384 + (pi - 8192));
        const double inv = dexp(-(double)fi * 0.125 * 13.122363377404328);
        double s, c; dsincos(pos * inv, s, c);
        ((float2*)(F.ws + WS_ROPE))[i] = make_float2((float)c, (float)s);
    }
    for (int i = gt; i < 32 * 64; i += NGT) {
        const int g = i >> 6, p = i & 63;
        const double are = (double)INP(16)[i], aim = (double)INP(17)[i], dt = dexp((double)INP(18)[g]);
        float* lamt = (float*)(F.ws + WS_SSM + SSM_LAMT);
        double lbr = 0, lbi = 0;
#pragma unroll
        for (int k = 0; k < 5; ++k) { const double pw = k < 4 ? (double)(k + 1) : 128.0; const double mag = dexp(are * dt * pw); double s, c; dsincos(aim * dt * pw, s, c);
            lamt[((g * 5 + k) * 64 + p) * 2 + 0] = (float)(mag * c); lamt[((g * 5 + k) * 64 + p) * 2 + 1] = (float)(mag * s); if (k == 0) { lbr = mag * c; lbi = mag * s; } }
        const double den = are * are + aim * aim, nre = lbr - 1.0, nim = lbi;
        const double cre = (nre * are + nim * aim) / den, cim = (nim * are - nre * aim) / den;
        bf16* bbf = (bf16*)(F.ws + WS_SSM + SSM_BBF); bf16* cmf = (bf16*)(F.ws + WS_SSM + SSM_CMF);
        for (int ch = 0; ch < 16; ++ch) {
            const double bre = (double)INP(19)[(size_t)i * 16 + ch], bim = (double)INP(20)[(size_t)i * 16 + ch];
            bbf[(g * 128 + p) * 16 + ch] = (bf16)f2bf((float)(cre * bre - cim * bim));
            bbf[(g * 128 + 64 + p) * 16 + ch] = (bf16)f2bf((float)(cre * bim + cim * bre));
            cmf[(g * 16 + ch) * 128 + p] = (bf16)f2bf(INP(21)[(g * 16 + ch) * 64 + p]);
            cmf[(g * 16 + ch) * 128 + 64 + p] = (bf16)f2bf(-INP(22)[(g * 16 + ch) * 64 + p]);
        }
    }
}

__device__ __forceinline__ void ew_pass(const Frame& F, const bf16* C, const float* gpost, float wgt, bool first, const float* gpre, bf16* XN) {
    const int gw = blockIdx.x * NWAVES + F.wave, NGW = F.G * NWAVES;
    for (int row = gw; row < M; row += NGW) {
        const v2u* cr = (const v2u*)(C + (size_t)row * D) + F.lane;
        const f32x4* hr = (const f32x4*)(first ? xrow_ptr(F, row) : F.out + (size_t)row * D) + F.lane;
        f32x4* ho = (f32x4*)(F.out + (size_t)row * D) + F.lane;
        f32x4 c[4], h[4]; float s = 0.f;
#pragma unroll
        for (int j = 0; j < 4; ++j) { const v2u w = cr[64 * j]; c[j] = (f32x4){pg8::bflo(w.x), pg8::bfhi(w.x), pg8::bflo(w.y), pg8::bfhi(w.y)}; h[j] = hr[64 * j];
            s += (c[j].x * c[j].x + c[j].y * c[j].y) + (c[j].z * c[j].z + c[j].w * c[j].w); }
        const float r = wgt / sqrtf(wave_sum(s) * (1.f / D) + EPS);
        float s2 = 0.f;
#pragma unroll
        for (int j = 0; j < 4; ++j) { const f32x4 gg = ((const f32x4*)gpost + F.lane)[64 * j]; h[j] = h[j] + c[j] * r * gg; ho[64 * j] = h[j];
            s2 += (h[j].x * h[j].x + h[j].y * h[j].y) + (h[j].z * h[j].z + h[j].w * h[j].w); }
        if (gpre) {
            const float r2 = 1.0f / sqrtf(wave_sum(s2) * (1.f / D) + EPS);
            v2u* o8 = (v2u*)(XN + (size_t)row * D) + F.lane;
#pragma unroll
            for (int j = 0; j < 4; ++j) { const f32x4 gg = ((const f32x4*)gpre + F.lane)[64 * j]; v2u w; w.x = pk2(h[j].x * r2 * gg.x, h[j].y * r2 * gg.y); w.y = pk2(h[j].z * r2 * gg.z, h[j].w * r2 * gg.w); o8[64 * j] = w; }
        }
    }
}
__device__ __forceinline__ void mix_pass(const Frame& F) {
    const int gw = blockIdx.x * NWAVES + F.wave, NGW = F.G * NWAVES;
    const bf16* YO = (const bf16*)(F.ws + WS_CB); bf16* XN = (bf16*)(F.ws + WS_XN);
    for (int row = gw; row < M; row += NGW) {
#pragma unroll
        for (int hf = 0; hf < 2; ++hf) {
            const v4u w = *((const v4u*)(YO + (size_t)row * D + hf * 512) + F.lane);
            float v[8] = {pg8::bflo(w.x), pg8::bfhi(w.x), pg8::bflo(w.y), pg8::bfhi(w.y), pg8::bflo(w.z), pg8::bfhi(w.z), pg8::bflo(w.w), pg8::bfhi(w.w)};
            float s = 0.f;
#pragma unroll
            for (int e = 0; e < 8; ++e) s += v[e] * v[e];
            const float r = 1.0f / sqrtf(wave_sum(s) * (1.f / 512.f) + EPS);
            const float* g = (hf == 0 ? INP(27) : INP(28)) + 8 * F.lane;
            const f32x4 g0 = *(const f32x4*)g, g1 = *(const f32x4*)(g + 4);
            v4u o; o.x = pk2(v[0] * r * g0.x, v[1] * r * g0.y); o.y = pk2(v[2] * r * g0.z, v[3] * r * g0.w); o.z = pk2(v[4] * r * g1.x, v[5] * r * g1.y); o.w = pk2(v[6] * r * g1.z, v[7] * r * g1.w);
            *((v4u*)(XN + (size_t)row * D + hf * 512) + F.lane) = o;
        }
    }
}

__device__ __forceinline__ float gelu_tanh(float y) {
    const float t = 0.7978845608028654f * (y + 0.044715f * y * y * y);
    const float th = 1.0f - 2.0f * __builtin_amdgcn_rcpf(1.0f + __expf(2.0f * t));
    return 0.5f * y * (1.0f + th);
}
template <bool PASS2>
__device__ __forceinline__ void ssm_unit(const Frame& F, int g, int row0, int ntok, float (&S)[4], LAS unsigned char* slds) {
    const int lane = F.lane, c = lane & 31, h = lane >> 5;
    const bf16* Z = (const bf16*)(F.ws + WS_Z);
    const bf16* bbf = (const bf16*)(F.ws + WS_SSM + SSM_BBF) + (size_t)g * 128 * 16;
    const float* lamt = (const float*)(F.ws + WS_SSM + SSM_LAMT) + (size_t)g * 5 * 64 * 2;
    bf16x8 Bf[4];
#pragma unroll
    for (int n = 0; n < 4; ++n) Bf[n] = *(const bf16x8*)(bbf + (32 * n + c) * 16 + 8 * h);
    float lr[2][4], li[2][4];
#pragma unroll
    for (int st = 0; st < 2; ++st)
#pragma unroll
        for (int k = 0; k < 4; ++k) { const float2 l = *(const float2*)(lamt + (k * 64 + 32 * st + c) * 2); lr[st][k] = l.x; li[st][k] = l.y; }
    bf16x8 Cf[4]; float dv = 0.f;
    if (PASS2) {
        const bf16* cmf = (const bf16*)(F.ws + WS_SSM + SSM_CMF) + (size_t)g * 16 * 128;
#pragma unroll
        for (int ks = 0; ks < 4; ++ks) Cf[ks] = *(const bf16x8*)(cmf + (lane & 15) * 128 + 32 * ks + 8 * (lane >> 4));
        dv = INP(23)[g * 16 + (lane & 15)];
    }
    const int nsub = (ntok + 31) >> 5, qe = ((ntok - 1) & 31) >> 2;
    float fin[4] = {0.f, 0.f, 0.f, 0.f};
    for (int sub = 0; sub < nsub; ++sub) {
        const int t0 = 32 * sub;
        bf16x8 Uf = (bf16x8){0, 0, 0, 0, 0, 0, 0, 0};
        if (t0 + c < ntok) Uf = *(const bf16x8*)(Z + (size_t)(row0 + t0 + c) * INW + g * 16 + 8 * h);
        f32x16 a[4];
#pragma unroll
        for (int n = 0; n < 4; ++n) { f32x16 z = {}; a[n] = __builtin_amdgcn_mfma_f32_32x32x16_bf16(Uf, Bf[n], z, 0, 0, 0); }
#pragma unroll
        for (int i = 0; i < 4; ++i)
#pragma unroll
            for (int k = 1; k < 4; ++k)
#pragma unroll
                for (int st = 0; st < 2; ++st) {
                    const float pr = a[st][4 * i + k - 1], pi = a[2 + st][4 * i + k - 1];
                    a[st][4 * i + k] += lr[st][0] * pr - li[st][0] * pi;
                    a[2 + st][4 * i + k] += lr[st][0] * pi + li[st][0] * pr;
                }
        float Sin[4][4];
#pragma unroll
        for (int q = 0; q < 8; ++q) {
            const int i = q >> 1;
            if ((q & 1) == 0) {
#pragma unroll
                for (int e = 0; e < 4; ++e) Sin[i][e] = S[e];
            } else {
#pragma unroll
                for (int e = 0; e < 4; ++e) Sin[i][e] = h ? S[e] : Sin[i][e];
            }
            float o[4];
            o[0] = lr[0][3] * S[0] - li[0][3] * S[1] + a[0][4 * i + 3]; o[1] = lr[0][3] * S[1] + li[0][3] * S[0] + a[2][4 * i + 3];
            o[2] = lr[1][3] * S[2] - li[1][3] * S[3] + a[1][4 * i + 3]; o[3] = lr[1][3] * S[3] + li[1][3] * S[2] + a[3][4 * i + 3];
#pragma unroll
            for (int e = 0; e < 4; ++e) S[e] = __shfl_xor(o[e], 32);
            if (sub == nsub - 1 && q == qe) {
#pragma unroll
                for (int e = 0; e < 4; ++e) fin[e] = S[e];
            }
        }
        if (PASS2) {
#pragma unroll
            for (int i = 0; i < 4; ++i)
#pragma unroll
                for (int k = 0; k < 4; ++k)
#pragma unroll
                    for (int st = 0; st < 2; ++st) {
                        const float sr = Sin[i][2 * st], si = Sin[i][2 * st + 1];
                        a[st][4 * i + k] += lr[st][k] * sr - li[st][k] * si;
                        a[2 + st][4 * i + k] += lr[st][k] * si + li[st][k] * sr;
                    }
#pragma unroll
            for (int i = 0; i < 4; ++i)
#pragma unroll
                for (int k = 0; k < 4; ++k) {
                    const int tok = 8 * i + 4 * h + k; LAS unsigned short* rp = (LAS unsigned short*)(slds + tok * 272) + c;
                    rp[0] = (unsigned short)f2bf(a[0][4 * i + k]); rp[32] = (unsigned short)f2bf(a[1][4 * i + k]); rp[64] = (unsigned short)f2bf(a[2][4 * i + k]); rp[96] = (unsigned short)f2bf(a[3][4 * i + k]);
                }
            asm volatile("s_waitcnt lgkmcnt(0)" ::: "memory");
            f32x4 Y[2];
#pragma unroll
            for (int mb = 0; mb < 2; ++mb) { Y[mb] = (f32x4){0.f, 0.f, 0.f, 0.f};
#pragma unroll
                for (int ks = 0; ks < 4; ++ks) { const bf16x8 Af = *(const LAS bf16x8*)(slds + (16 * mb + (lane & 15)) * 272 + (32 * ks + 8 * (lane >> 4)) * 2);
                    Y[mb] = __builtin_amdgcn_mfma_f32_16x16x32_bf16(Af, Cf[ks], Y[mb], 0, 0, 0); } }
            asm volatile("s_waitcnt lgkmcnt(0)" ::: "memory");
            bf16* Gb = (bf16*)(F.ws + WS_G);
#pragma unroll
            for (int mb = 0; mb < 2; ++mb)
#pragma unroll
                for (int r = 0; r < 4; ++r) {
                    const int tok = t0 + 16 * mb + 4 * (lane >> 4) + r;
                    if (tok < ntok) { const size_t row = (size_t)(row0 + tok); const float uval = bf2f(Z[row * INW + g * 16 + (lane & 15)]);
                        Gb[row * 512 + g * 16 + (lane & 15)] = (bf16)f2bf(gelu_tanh(Y[mb][r] + dv * uval)); }
                }
        }
    }
#pragma unroll
    for (int e = 0; e < 4; ++e) S[e] = fin[e];
}
__device__ __forceinline__ void ssm_pass1(const Frame& F) {
    const int gw = blockIdx.x * NWAVES + F.wave, NGW = F.G * NWAVES;
    float* E = (float*)(F.ws + WS_E);
    for (int u = gw; u < NB * 63 * 32; u += NGW) {
        const int g = u & 31, cch = (u >> 5) % 63, b = (u >> 5) / 63;
        float S[4] = {0.f, 0.f, 0.f, 0.f};
        ssm_unit<false>(F, g, b * SEQ + cch * 128, 128, S, F.lds);
        if (F.lane < 32) { float* e = E + ((size_t)(b * 32 + g) * 64 + cch) * 128 + F.lane; e[0] = S[0]; e[64] = S[1]; e[32] = S[2]; e[96] = S[3]; }
    }
}
__device__ __forceinline__ void ssm_pass2(const Frame& F) {
    const int gw = blockIdx.x * NWAVES + F.wave, NGW = F.G * NWAVES;
    const float* E = (const float*)(F.ws + WS_E);
    LAS unsigned char* slds = F.lds + F.wave * 8704;
    const int c = F.lane & 31;
    for (int u = gw; u < NB * 64 * 32 + DB * 32; u += NGW) {
        if (u < NB * 64 * 32) {
            const int g = u & 31, cch = (u >> 5) & 63, b = u >> 11;
            const float* lamt = (const float*)(F.ws + WS_SSM + SSM_LAMT) + (size_t)g * 5 * 64 * 2;
            const float2 L0 = *(const float2*)(lamt + (4 * 64 + c) * 2), L1 = *(const float2*)(lamt + (4 * 64 + 32 + c) * 2);
            float S[4] = {0.f, 0.f, 0.f, 0.f};
            const float* e = E + ((size_t)(b * 32 + g) * 64) * 128 + c;
            for (int j = 0; j < cch; ++j) {
                const float e0 = e[j * 128], e1 = e[j * 128 + 64], e2 = e[j * 128 + 32], e3 = e[j * 128 + 96];
                const float n0 = L0.x * S[0] - L0.y * S[1] + e0, n1 = L0.x * S[1] + L0.y * S[0] + e1, n2 = L1.x * S[2] - L1.y * S[3] + e2, n3 = L1.x * S[3] + L1.y * S[2] + e3;
                S[0] = n0; S[1] = n1; S[2] = n2; S[3] = n3;
            }
            ssm_unit<true>(F, g, b * SEQ + cch * 128, 128, S, slds);
            if (cch == 63 && F.lane < 32) { float* ore = F.out + O_PSRE + (size_t)(b * 32 + g) * 64 + c; float* oim = F.out + O_PSIM + (size_t)(b * 32 + g) * 64 + c;
                ore[0] = S[0]; oim[0] = S[1]; ore[32] = S[2]; oim[32] = S[3]; }
        } else {
            const int v = u - NB * 64 * 32, g = v & 31, b = v >> 5;
            const float* sre = INP(2) + (size_t)(b * 32 + g) * 64 + c; const float* sim = INP(3) + (size_t)(b * 32 + g) * 64 + c;
            float S[4] = {sre[0], sim[0], sre[32], sim[32]};
            ssm_unit<true>(F, g, NPROW + 4 * b, 4, S, slds);
            if (F.lane >= 32) { float* ore = F.out + O_SSRE + (size_t)(b * 32 + g) * 64 + c; float* oim = F.out + O_SSIM + (size_t)(b * 32 + g) * 64 + c;
                ore[0] = S[0]; oim[0] = S[1]; ore[32] = S[2]; oim[32] = S[3]; }
        }
    }
}

__device__ __forceinline__ void swa_prompt_unit(const Frame& F, int unit) {
    const int kvh = unit & 1, qblk = (unit >> 1) & 63, b = unit >> 7;
    const int tid = F.tid, lane = F.lane, w = F.wave, l15 = lane & 15, quad = lane >> 4;
    const bf16* Z = (const bf16*)(F.ws + WS_Z); bf16* YO = (bf16*)(F.ws + WS_CB);
    LAS unsigned char* Kl = F.lds; LAS unsigned char* Vl = F.lds + 36864;
    const int rowb = b * SEQ + qblk * 128;
    { const int d = tid >> 3, wq = tid & 7; *(LAS unsigned*)(Vl + d * 544 + 512 + 4 * wq) = 0u; }
#pragma unroll
    for (int i = 0; i < 4; ++i) {
        const int idx = tid + 512 * i, key = idx >> 3, ch = idx & 7;
        v4u kv = {0u, 0u, 0u, 0u}, vv = {0u, 0u, 0u, 0u};
        if (qblk > 0 || key >= 128) { const bf16* zr = Z + (size_t)(rowb - 128 + key) * INW; kv = *(const v4u*)(zr + 1024 + kvh * 64 + ch * 8); vv = *(const v4u*)(zr + 1152 + kvh * 64 + ch * 8); }
        *(LAS v4u*)(Kl + key * 144 + ch * 16) = kv;
        LAS unsigned short* vp = (LAS unsigned short*)(Vl + (8 * ch) * 544) + key;
        vp[0 * 272] = (unsigned short)vv.x; vp[1 * 272] = (unsigned short)(vv.x >> 16); vp[2 * 272] = (unsigned short)vv.y; vp[3 * 272] = (unsigned short)(vv.y >> 16);
        vp[4 * 272] = (unsigned short)vv.z; vp[5 * 272] = (unsigned short)(vv.z >> 16); vp[6 * 272] = (unsigned short)vv.w; vp[7 * 272] = (unsigned short)(vv.w >> 16);
        if (qblk == 63 && key >= 128) {
            float* ok = F.out + O_PWK + ((size_t)(b * 128 + key - 128) * 2 + kvh) * 64 + ch * 8; float* ov = F.out + O_PWV + ((size_t)(b * 128 + key - 128) * 2 + kvh) * 64 + ch * 8;
            *(f32x4*)ok = (f32x4){pg8::bflo(kv.x), pg8::bfhi(kv.x), pg8::bflo(kv.y), pg8::bfhi(kv.y)}; *(f32x4*)(ok + 4) = (f32x4){pg8::bflo(kv.z), pg8::bfhi(kv.z), pg8::bflo(kv.w), pg8::bfhi(kv.w)};
            *(f32x4*)ov = (f32x4){pg8::bflo(vv.x), pg8::bfhi(vv.x), pg8::bflo(vv.y), pg8::bfhi(vv.y)}; *(f32x4*)(ov + 4) = (f32x4){pg8::bflo(vv.z), pg8::bfhi(vv.z), pg8::bflo(vv.w), pg8::bfhi(vv.w)};
        }
    }
    __syncthreads();
    const int hq = kvh * 4 + (w >> 1);
    const float sink = INP(26)[hq];
    for (int i = 0; i < 4; ++i) {
        const int a = (w & 1) * 64 + 16 * i, A = a >> 4, iq = a + l15;
        const bf16* qrow = Z + (size_t)(rowb + iq) * INW + 512 + hq * 64 + 8 * quad;
        const bf16x8 Q0 = *(const bf16x8*)qrow, Q1 = *(const bf16x8*)(qrow + 32);
        f32x4 s[9];
#pragma unroll
        for (int nn = 0; nn < 9; ++nn) {
            const LAS unsigned char* kp = Kl + (16 * (A + nn) + l15) * 144 + 16 * quad;
            f32x4 acc = {0.f, 0.f, 0.f, 0.f};
            acc = __builtin_amdgcn_mfma_f32_16x16x32_bf16(*(const LAS bf16x8*)kp, Q0, acc, 0, 0, 0);
            acc = __builtin_amdgcn_mfma_f32_16x16x32_bf16(*(const LAS bf16x8*)(kp + 64), Q1, acc, 0, 0, 0);
            s[nn] = acc;
        }
        float mx = sink;
#pragma unroll
        for (int nn = 0; nn < 9; ++nn)
#pragma unroll
            for (int r = 0; r < 4; ++r) { const int j = 16 * (A + nn) + 4 * quad + r; const bool valid = (j >= iq) && (j <= iq + 128) && (qblk > 0 || j >= 128);
                const float v = valid ? s[nn][r] * 0.125f : -1e30f; s[nn][r] = v; mx = fmaxf(mx, v); }
        mx = fmaxf(mx, __shfl_xor(mx, 16)); mx = fmaxf(mx, __shfl_xor(mx, 32));
        float sum = 0.f;
#pragma unroll
        for (int nn = 0; nn < 9; ++nn)
#pragma unroll
            for (int r = 0; r < 4; ++r) { const float e = __expf(s[nn][r] - mx); s[nn][r] = e; sum += e; }
        sum += __shfl_xor(sum, 16); sum += __shfl_xor(sum, 32);
        const float inv = 1.0f / (sum + __expf(sink - mx));
        bf16x8 P[5];
#pragma unroll
        for (int kk = 0; kk < 5; ++kk) {
            v4u pw; pw.x = pk2(s[2 * kk][0] * inv, s[2 * kk][1] * inv); pw.y = pk2(s[2 * kk][2] * inv, s[2 * kk][3] * inv);
            if (kk < 4) { pw.z = pk2(s[2 * kk + 1][0] * inv, s[2 * kk + 1][1] * inv); pw.w = pk2(s[2 * kk + 1][2] * inv, s[2 * kk + 1][3] * inv); } else { pw.z = 0u; pw.w = 0u; }
            P[kk] = __builtin_bit_cast(bf16x8, pw);
        }
        f32x4 O[4];
#pragma unroll
        for (int db = 0; db < 4; ++db) { O[db] = (f32x4){0.f, 0.f, 0.f, 0.f};
#pragma unroll
            for (int kk = 0; kk < 5; ++kk) {
                const LAS unsigned char* vp = Vl + (16 * db + l15) * 544 + (16 * (A + 2 * kk) + 4 * quad) * 2;
                const v2u lo = *(const LAS v2u*)vp, hi = *(const LAS v2u*)(vp + 32);
                const v4u vf = {lo.x, lo.y, hi.x, hi.y};
                O[db] = __builtin_amdgcn_mfma_f32_16x16x32_bf16(__builtin_bit_cast(bf16x8, vf), P[kk], O[db], 0, 0, 0);
            } }
        bf16* orow = YO + (size_t)(rowb + iq) * D + 512 + hq * 64 + 4 * quad;
#pragma unroll
        for (int db = 0; db < 4; ++db) { v2u o; o.x = pk2(O[db][0], O[db][1]); o.y = pk2(O[db][2], O[db][3]); *(v2u*)(orow + 16 * db) = o; }
    }
    __syncthreads();
}
__device__ __forceinline__ void swa_sample_unit(const Frame& F, int unit) {
    const int kvh = unit & 1, b = unit >> 1, tid = F.tid, lane = F.lane, w = F.wave;
    const bf16* Z = (const bf16*)(F.ws + WS_Z); bf16* YO = (bf16*)(F.ws + WS_CB);
    LAS float* Kf = (LAS float*)F.lds;
    LAS float* Vf = (LAS float*)(F.lds + 34320);
    LAS float* Qf = (LAS float*)(F.lds + 68112);
    LAS float* Pf = (LAS float*)(F.lds + 72208) + w * 136;
    const int rowb = NPROW + 4 * b;
    for (int idx = tid; idx < 132 * 16; idx += NTHR) {
        const int j = idx >> 4, c4 = (idx & 15) * 4;
        f32x4 kv, vv;
        if (j < 128) { kv = *(const f32x4*)(INP(4) + ((size_t)(b * 128 + j) * 2 + kvh) * 64 + c4); vv = *(const f32x4*)(INP(5) + ((size_t)(b * 128 + j) * 2 + kvh) * 64 + c4); }
        else { const bf16* zr = Z + (size_t)(rowb + j - 128) * INW; const v2u kw = *(const v2u*)(zr + 1024 + kvh * 64 + c4), vw = *(const v2u*)(zr + 1152 + kvh * 64 + c4);
            kv = (f32x4){pg8::bflo(kw.x), pg8::bfhi(kw.x), pg8::bflo(kw.y), pg8::bfhi(kw.y)}; vv = (f32x4){pg8::bflo(vw.x), pg8::bfhi(vw.x), pg8::bflo(vw.y), pg8::bfhi(vw.y)}; }
        Kf[j * 65 + c4] = kv.x; Kf[j * 65 + c4 + 1] = kv.y; Kf[j * 65 + c4 + 2] = kv.z; Kf[j * 65 + c4 + 3] = kv.w;
        *(LAS f32x4*)(Vf + j * 64 + c4) = vv;
        if (j >= 4) { *(f32x4*)(F.out + O_SWK + ((size_t)(b * 128 + j - 4) * 2 + kvh) * 64 + c4) = kv; *(f32x4*)(F.out + O_SWV + ((size_t)(b * 128 + j - 4) * 2 + kvh) * 64 + c4) = vv; }
    }
    for (int idx = tid; idx < 16 * 64; idx += NTHR) { const int qr = idx >> 6, d = idx & 63, t = qr >> 2, hl = qr & 3;
        Qf[idx] = 0.125f * bf2f(Z[(size_t)(rowb + t) * INW + 512 + (kvh * 4 + hl) * 64 + d]); }
    __syncthreads();
    const int hl = w & 3, hq = kvh * 4 + hl; const float sink = INP(26)[hq];
    for (int tt = 0; tt < 2; ++tt) {
        const int t = 2 * (w >> 2) + tt; const LAS float* q = Qf + (t * 4 + hl) * 64;
        float s[3]; float mx = sink;
#pragma unroll
        for (int cc = 0; cc < 3; ++cc) { const int j = lane + 64 * cc; float acc = 0.f;
            if (j < 132) { const LAS float* kr = Kf + j * 65;
#pragma unroll 16
                for (int d = 0; d < 64; ++d) acc += q[d] * kr[d]; }
            const bool valid = (j < 132) && (j >= t) && (j <= 128 + t); s[cc] = valid ? acc : -1e30f; mx = fmaxf(mx, s[cc]); }
        mx = wave_max(mx);
        float sum = 0.f;
#pragma unroll
        for (int cc = 0; cc < 3; ++cc) { s[cc] = __expf(s[cc] - mx); sum += s[cc]; }
        sum = wave_sum(sum);
        const float inv = 1.0f / (sum + __expf(sink - mx));
#pragma unroll
        for (int cc = 0; cc < 3; ++cc) { const int j = lane + 64 * cc; if (j < 132) Pf[j] = s[cc] * inv; }
        asm volatile("s_waitcnt lgkmcnt(0)" ::: "memory");
        float o = 0.f;
#pragma unroll 4
        for (int j = 0; j < 132; ++j) o += Pf[j] * Vf[j * 64 + lane];
        YO[(size_t)(rowb + t) * D + 512 + hq * 64 + lane] = (bf16)f2bf(o);
        asm volatile("s_waitcnt lgkmcnt(0)" ::: "memory");
    }
    __syncthreads();
}

__device__ __forceinline__ void xattn_prompt_unit(const Frame& F, int unit) {
    const int qb = unit & 31, hd = (unit >> 5) & 3, b = unit >> 7;
    const int tid = F.tid, lane = F.lane, w = F.wave, l15 = lane & 15, quad = lane >> 4;
    const bf16* Q2 = (const bf16*)(F.ws + WS_Q2); bf16* O2 = (bf16*)(F.ws + WS_O2);
    const bf16* MK = (const bf16*)(F.ws + WS_MK); const bf16* MVT = (const bf16*)(F.ws + WS_MVT);
    LAS unsigned char* L = F.lds;
    const int rowb = b * SEQ + qb * 256 + w * 32;
#pragma unroll
    for (int i = 0; i < 16; ++i) { const int idx = tid + 512 * i, key = idx >> 5, ch = idx & 31;
        *(LAS v4u*)(L + key * 528 + ch * 16) = *(const v4u*)(MK + (size_t)(b * 256 + key) * 1024 + hd * 256 + ch * 8); }
    __syncthreads();
    bf16x8 P[2][8];
#pragma unroll
    for (int qi = 0; qi < 2; ++qi) {
        const bf16* qrow = Q2 + (size_t)(rowb + qi * 16 + l15) * D + hd * 256 + 8 * quad;
        bf16x8 Qf[8];
#pragma unroll
        for (int ks = 0; ks < 8; ++ks) Qf[ks] = *(const bf16x8*)(qrow + 32 * ks);
        f32x4 s[16]; float mx = -1e30f;
#pragma unroll
        for (int kb = 0; kb < 16; ++kb) { f32x4 acc = {0.f, 0.f, 0.f, 0.f}; const LAS unsigned char* kp = L + (16 * kb + l15) * 528 + 16 * quad;
#pragma unroll
            for (int ks = 0; ks < 8; ++ks) acc = __builtin_amdgcn_mfma_f32_16x16x32_bf16(*(const LAS bf16x8*)(kp + 64 * ks), Qf[ks], acc, 0, 0, 0);
            s[kb] = acc; mx = fmaxf(fmaxf(mx, fmaxf(acc[0], acc[1])), fmaxf(acc[2], acc[3])); if (kb & 1) __builtin_amdgcn_sched_barrier(0); }
        mx = fmaxf(mx, __shfl_xor(mx, 16)); mx = fmaxf(mx, __shfl_xor(mx, 32));
        float sum = 0.f;
#pragma unroll
        for (int kb = 0; kb < 16; ++kb)
#pragma unroll
            for (int r = 0; r < 4; ++r) { const float e = __expf((s[kb][r] - mx) * 0.0625f); s[kb][r] = e; sum += e; }
        sum += __shfl_xor(sum, 16); sum += __shfl_xor(sum, 32);
        const float inv = 1.0f / sum;
#pragma unroll
        for (int kk = 0; kk < 8; ++kk) { v4u pw; pw.x = pk2(s[2 * kk][0] * inv, s[2 * kk][1] * inv); pw.y = pk2(s[2 * kk][2] * inv, s[2 * kk][3] * inv);
            pw.z = pk2(s[2 * kk + 1][0] * inv, s[2 * kk + 1][1] * inv); pw.w = pk2(s[2 * kk + 1][2] * inv, s[2 * kk + 1][3] * inv); P[qi][kk] = __builtin_bit_cast(bf16x8, pw); }
    }
    __syncthreads();
#pragma unroll
    for (int i = 0; i < 16; ++i) { const int idx = tid + 512 * i, d = idx >> 5, ch = idx & 31;
        *(LAS v4u*)(L + d * 528 + ch * 16) = *(const v4u*)(MVT + ((size_t)(b * 4 + hd) * 256 + d) * 256 + ch * 8); }
    __syncthreads();
#pragma unroll
    for (int qi = 0; qi < 2; ++qi) {
        f32x4 O[16];
#pragma unroll
        for (int db = 0; db < 16; ++db) O[db] = (f32x4){0.f, 0.f, 0.f, 0.f};
#pragma unroll
        for (int kk = 0; kk < 8; ++kk) {
#pragma unroll
            for (int db = 0; db < 16; ++db) { const LAS unsigned char* vp = L + (16 * db + l15) * 528 + (32 * kk + 4 * quad) * 2;
                const v2u lo = *(const LAS v2u*)vp, hi = *(const LAS v2u*)(vp + 32); const v4u vf = {lo.x, lo.y, hi.x, hi.y};
                O[db] = __builtin_amdgcn_mfma_f32_16x16x32_bf16(__builtin_bit_cast(bf16x8, vf), P[qi][kk], O[db], 0, 0, 0);
                if ((db & 7) == 7) __builtin_amdgcn_sched_barrier(0); } }
        bf16* orow = O2 + (size_t)(rowb + qi * 16 + l15) * D + hd * 256 + 4 * quad;
#pragma unroll
        for (int db = 0; db < 16; ++db) { v2u o; o.x = pk2(O[db][0], O[db][1]); o.y = pk2(O[db][2], O[db][3]); *(v2u*)(orow + 16 * db) = o; }
    }
    __syncthreads();
}
__device__ __forceinline__ void xattn_sample_unit(const Frame& F, int unit) {
    const int hd = unit & 3, b = unit >> 2, tid = F.tid, lane = F.lane, w = F.wave;
    const bf16* Q2 = (const bf16*)(F.ws + WS_Q2); bf16* O2 = (bf16*)(F.ws + WS_O2);
    LAS float* SC = (LAS float*)F.lds;
    LAS float* OP = (LAS float*)(F.lds + 4096);
    const int rowb = NPROW + 4 * b;
    f32x4 q[4];
#pragma unroll
    for (int t = 0; t < 4; ++t) { const v2u wq = *(const v2u*)(Q2 + (size_t)(rowb + t) * D + hd * 256 + 4 * lane); q[t] = (f32x4){pg8::bflo(wq.x), pg8::bfhi(wq.x), pg8::bflo(wq.y), pg8::bfhi(wq.y)}; }
    const float* kbase = INP(6) + ((size_t)(b * 256 + w * 32) * 4 + hd) * 256 + 4 * lane;
    const float* vbase = INP(7) + ((size_t)(b * 256 + w * 32) * 4 + hd) * 256 + 4 * lane;
#pragma unroll 8
    for (int i = 0; i < 32; ++i) {
        const f32x4 kv = *(const f32x4*)(kbase + (size_t)i * 1024);
        float p[4];
#pragma unroll
        for (int t = 0; t < 4; ++t) p[t] = (q[t].x * kv.x + q[t].y * kv.y) + (q[t].z * kv.z + q[t].w * kv.w);
#pragma unroll
        for (int o = 1; o < 64; o <<= 1) {
#pragma unroll
            for (int t = 0; t < 4; ++t) p[t] += __shfl_xor(p[t], o); }
        if (lane < 4) SC[lane * 256 + w * 32 + i] = (lane == 0 ? p[0] : lane == 1 ? p[1] : lane == 2 ? p[2] : p[3]) * 0.0625f;
    }
    __syncthreads();
    if (w < 4) {
        float s[4]; float mx = -1e30f;
#pragma unroll
        for (int j = 0; j < 4; ++j) { s[j] = SC[w * 256 + lane + 64 * j]; mx = fmaxf(mx, s[j]); }
        mx = wave_max(mx); float sum = 0.f;
#pragma unroll
        for (int j = 0; j < 4; ++j) { s[j] = __expf(s[j] - mx); sum += s[j]; }
        sum = wave_sum(sum); const float inv = 1.0f / sum;
#pragma unroll
        for (int j = 0; j < 4; ++j) SC[w * 256 + lane + 64 * j] = s[j] * inv;
    }
    __syncthreads();
    f32x4 o[4];
#pragma unroll
    for (int t = 0; t < 4; ++t) o[t] = (f32x4){0.f, 0.f, 0.f, 0.f};
#pragma unroll 8
    for (int i = 0; i < 32; ++i) {
        const f32x4 vv = *(const f32x4*)(vbase + (size_t)i * 1024);
#pragma unroll
        for (int t = 0; t < 4; ++t) { const float p = SC[t * 256 + w * 32 + i]; o[t] = o[t] + vv * p; }
    }
#pragma unroll
    for (int t = 0; t < 4; ++t) *(LAS f32x4*)(OP + (w * 4 + t) * 256 + 4 * lane) = o[t];
    __syncthreads();
#pragma unroll
    for (int k = 0; k < 2; ++k) { const int idx = tid + 512 * k, t = idx >> 8, d = idx & 255; float acc = 0.f;
#pragma unroll
        for (int ww = 0; ww < 8; ++ww) acc += OP[(ww * 4 + t) * 256 + d];
        O2[(size_t)(rowb + t) * D + hd * 256 + d] = (bf16)f2bf(acc); }
    __syncthreads();
}


__device__ __forceinline__ void run_gu(const Frame& F, size_t woff, int cid) {
    pg8::Gemm g{(const bf16*)(F.ws + WS_XN), (const bf16*)(F.ws + woff), M, 2 * FF, D}; pg8::StaticOrder S; S.init(M, 2 * FF, F.G, cid);
    pg8::EpiSwiglu E{(bf16*)(F.ws + WS_ACT), FF};
    pg8::gemm_phase<pg8::EpiSwiglu, pg8::StaticOrder, true, true>(F.lds, g, S, E);
}
__device__ __forceinline__ void run_plain(const Frame& F, size_t aoff, size_t boff, size_t ooff, int K, int cid) {
    pg8::Gemm g{(const bf16*)(F.ws + aoff), (const bf16*)(F.ws + boff), M, D, K}; pg8::StaticOrder S; S.init(M, D, F.G, cid);
    pg8::EpiPlain E{(bf16*)(F.ws + ooff), D};
    pg8::gemm_phase<pg8::EpiPlain, pg8::StaticOrder, true, true>(F.lds, g, S, E);
}
enum { PH_P0 = 0, PH_GU1, PH_DN1, PH_EW1, PH_WIN, PH_MIXA, PH_SSM2, PH_GLU, PH_MIXN, PH_WOUT, PH_EW2, PH_MEMQ, PH_XATT, PH_MEMO, PH_EW3, PH_GU2, PH_DN2, PH_EW4, PH_COUNT };

__global__ void __launch_bounds__(NTHR, 2) fwd_megakernel(Args args) {
    extern __shared__ __attribute__((aligned(16))) unsigned char lds_raw[];
    cg::grid_group grid = cg::this_grid();
    Frame F;
    F.lds = (LAS unsigned char*)lds_raw;
    F.tid = threadIdx.x; F.lane = F.tid & 63; F.wave = __builtin_amdgcn_readfirstlane(F.tid >> 6); F.G = gridDim.x;
    F.in = args.in; F.out = args.out; F.ws = args.ws;
    unsigned char* ws = args.ws;
    const int cid = (int)blockIdx.x;
    const int lo = args.ph_lo, hi = args.ph_hi;
#define IN_PH(k) (lo <= (k) && (k) < hi)
#define SEAM(k) do { if (IN_PH(k) && IN_PH((k) + 1)) grid.sync(); } while (0)
    if (IN_PH(PH_P0)) p0_prologue(F);
    SEAM(PH_P0);
    if (IN_PH(PH_GU1)) run_gu(F, WS_W1GU, cid);
    SEAM(PH_GU1);
    if (IN_PH(PH_DN1)) run_plain(F, WS_ACT, WS_W1D, WS_CB, FF, cid);
    SEAM(PH_DN1);
    if (IN_PH(PH_EW1)) ew_pass(F, (const bf16*)(ws + WS_CB), INP(13), 0.5f, true, INP(14), (bf16*)(ws + WS_XN));
    SEAM(PH_EW1);
    if (IN_PH(PH_WIN)) {
        { pg8::Gemm g{(const bf16*)(ws + WS_XN), (const bf16*)(ws + WS_WIN), M, INW, D}; pg8::StaticOrder S; S.init(M, INW, F.G, cid);
          pg8::EpiWin E{(bf16*)(ws + WS_Z), (const float2*)(ws + WS_ROPE)};
          pg8::gemm_phase<pg8::EpiWin, pg8::StaticOrder, true, true>(F.lds, g, S, E); }
        { pg8::Gemm g{(const bf16*)(ws + WS_MN), (const bf16*)(ws + WS_WMKV), 1024, 2048, D}; pg8::StaticOrder S; S.init(1024, 2048, F.G, (cid + F.G - (650 % F.G)) % F.G);
          pg8::EpiMemKV E{F.out + O_PMK, F.out + O_PMV, (bf16*)(ws + WS_MK), (bf16*)(ws + WS_MVT)};
          pg8::gemm_phase<pg8::EpiMemKV, pg8::StaticOrder, true, true>(F.lds, g, S, E); }
    }
    SEAM(PH_WIN);
    if (IN_PH(PH_MIXA)) {
        for (int u = cid; u < 512; u += F.G) swa_prompt_unit(F, u);
        for (int u = cid; u < 256; u += F.G) swa_sample_unit(F, u);
        ssm_pass1(F);
    }
    SEAM(PH_MIXA);
    if (IN_PH(PH_SSM2)) ssm_pass2(F);
    SEAM(PH_SSM2);
    if (IN_PH(PH_GLU)) {
        pg8::Gemm g{(const bf16*)(ws + WS_G), (const bf16*)(ws + WS_WGLU), M, 512, 512}; pg8::StaticOrder S; S.init(M, 512, F.G, cid);
        pg8::EpiGlu E{(const bf16*)(ws + WS_G), INP(25), (bf16*)(ws + WS_CB), D};
        pg8::gemm_phase<pg8::EpiGlu, pg8::StaticOrder, true, true>(F.lds, g, S, E);
    }
    SEAM(PH_GLU);
    if (IN_PH(PH_MIXN)) mix_pass(F);
    SEAM(PH_MIXN);
    if (IN_PH(PH_WOUT)) run_plain(F, WS_XN, WS_WOUT, WS_CB, D, cid);
    SEAM(PH_WOUT);
    if (IN_PH(PH_EW2)) ew_pass(F, (const bf16*)(ws + WS_CB), INP(30), 1.0f, false, INP(36), (bf16*)(ws + WS_XN));
    SEAM(PH_EW2);
    if (IN_PH(PH_MEMQ)) run_plain(F, WS_XN, WS_WMQ, WS_Q2, D, cid);
    SEAM(PH_MEMQ);
    if (IN_PH(PH_XATT)) {
        if (cid & 1) { for (int u = cid; u < 512; u += F.G) xattn_sample_unit(F, u); for (int u = cid; u < 512; u += F.G) xattn_prompt_unit(F, u); }
        else { for (int u = cid; u < 512; u += F.G) xattn_prompt_unit(F, u); for (int u = cid; u < 512; u += F.G) xattn_sample_unit(F, u); }
    }
    SEAM(PH_XATT);
    if (IN_PH(PH_MEMO)) run_plain(F, WS_O2, WS_WMO, WS_CB, D, cid);
    SEAM(PH_MEMO);
    if (IN_PH(PH_EW3)) ew_pass(F, (const bf16*)(ws + WS_CB), INP(37), 1.0f, false, INP(38), (bf16*)(ws + WS_XN));
    SEAM(PH_EW3);
    if (IN_PH(PH_GU2)) run_gu(F, WS_W2GU, cid);
    SEAM(PH_GU2);
    if (IN_PH(PH_DN2)) run_plain(F, WS_ACT, WS_W2D, WS_CB, FF, cid);
    SEAM(PH_DN2);
    if (IN_PH(PH_EW4)) ew_pass(F, (const bf16*)(ws + WS_CB), INP(42), 0.5f, false, nullptr, nullptr);
}

extern "C" void kernel_launch(void* const* d_in, const int* in_sizes, int n_in, void* d_out, int out_size, void* d_ws, size_t ws_size, hipStream_t stream) {
    static int grid = 0;
    if (grid == 0) {
        if (n_in != 43 || out_size != (int)O_END || ws_size < WS_END) { fprintf(stderr, "kernel_launch: unexpected sizes n_in %d out %d ws %zu\n", n_in, out_size, ws_size); grid = -1; return; }
        int dev = 0, cus = 0, per_cu = 0;
        hipGetDevice(&dev); hipDeviceGetAttribute(&cus, hipDeviceAttributeMultiprocessorCount, dev);
        hipFuncSetAttribute((const void*)fwd_megakernel, hipFuncAttributeMaxDynamicSharedMemorySize, LDS_BYTES);
        hipOccupancyMaxActiveBlocksPerMultiprocessor(&per_cu, (const void*)fwd_megakernel, NTHR, LDS_BYTES);
        if (per_cu < 1) { fprintf(stderr, "kernel_launch: occupancy query says %d blocks/CU\n", per_cu); per_cu = 1; }
        (void)hipGetLastError();
        grid = cus;
    }
    if (grid < 0) return;
    Args a{};
    for (int i = 0; i < 43; ++i) a.in[i] = (const float*)d_in[i];
    a.out = (float*)d_out; a.ws = (unsigned char*)d_ws; a.ph_lo = 0; a.ph_hi = PH_COUNT;
    void* kargs[] = {&a};
    hipError_t e = hipLaunchCooperativeKernel((const void*)fwd_megakernel, dim3(grid), dim3(NTHR), kargs, LDS_BYTES, stream);
    if (e != hipSuccess) fprintf(stderr, "cooperative launch failed: %s (grid %d)\n", hipGetErrorString(e), grid);
}
```

```cpp
#include <hip/hip_runtime.h>
#include <cstdio>
#include <cstdint>
namespace pg8 {
#define PG8_LAS __attribute__((address_space(3)))
typedef unsigned short bf16_t;
typedef short bf16x8 __attribute__((ext_vector_type(8)));
typedef float f32x4 __attribute__((ext_vector_type(4)));
typedef unsigned u32x4 __attribute__((ext_vector_type(4)));
constexpr int BM = 256, BK = 64, HALF = 128, HTB = HALF * BK * 2  , STAGE_BYTES = 8 * HTB, NXCD = 8, WGM = 8;

__host__ __device__ __forceinline__ int lds_byte(int r, int c) { const int st = (r >> 4) * 2 + (c >> 5), rr = r & 15, cc = c & 31, ob = rr * 64 + cc * 2; return st * 1024 + (ob ^ (((ob >> 9) & 1) << 5)); }
__host__ __device__ __forceinline__ void stage_rc(int b, int& R, int& C) { const int st = b / 1024, sb = b % 1024, swz = sb ^ (((sb >> 9) & 1) << 5); R = (st >> 1) * 16 + swz / 64; C = (st & 1) * 32 + (swz % 64) / 2; }
__host__ __device__ __forceinline__ int perm32(int rho) { const int n = rho >> 4, i = rho & 15; return 8 * (i >> 2) + 4 * n + (i & 3); }

struct Unit { int pm, pn, k0 = 0; };
struct Gemm { const bf16_t* A; const bf16_t* Bt; int M, N, K, ld; };

struct StaticOrder {
    int nM, nN, nwg, G, c;
    __host__ __device__ void init(int M, int N, int G_, int c_) { nM = M / BM; nN = N / BM; nwg = nM * nN; G = G_; c = c_; }
    __host__ __device__ bool next(int i, Unit& u) const {
        const long L = (long)i * G + c; if (L >= nwg) return false;
        int wgid = (int)L; { const int q = nwg / NXCD, r = nwg % NXCD, xcd = wgid % NXCD, off = wgid / NXCD; wgid = (xcd < r ? xcd * (q + 1) : r * (q + 1) + (xcd - r) * q) + off; }
        const int nig = WGM * nN, gid = wgid / nig, fm = gid * WGM, gsz = (nM - fm) < WGM ? (nM - fm) : WGM;
        u.pm = fm + ((wgid % nig) % gsz); u.pn = (wgid % nig) / gsz; return true;
    }
    __device__ __forceinline__ void a_ready(const Unit&) const {}
    __device__ __forceinline__ void done(const Unit&) const {}
};

__device__ __forceinline__ unsigned cvt_pk_bf16(float lo, float hi) { unsigned r; asm volatile("v_cvt_pk_bf16_f32 %0, %1, %2" : "=v"(r) : "v"(lo), "v"(hi)); return r; }
typedef float f32x2 __attribute__((ext_vector_type(2)));
__device__ __forceinline__ f32x2 gelu_pk(f32x2 v) {
    const f32x2 av = __builtin_elementwise_abs(v), d = av * 0.2316418882f + 1.0f;
    f32x2 t; t.x = __builtin_amdgcn_rcpf(d.x); t.y = __builtin_amdgcn_rcpf(d.y);
    f32x2 q = t * 0.5307027145f + (-0.7265760135f); q = q * t + 0.7107068705f; q = q * t + (-0.142248368f); q = q * t + 0.127414796f; q = q * t;
    const f32x2 s = (v * v) * (-0.72134752044f);
    f32x2 e; e.x = __builtin_amdgcn_exp2f(s.x); e.y = __builtin_amdgcn_exp2f(s.y);
    const f32x2 m = v * (q * e), r = v - m;
    f32x2 o; o.x = v.x < 0.f ? m.x : r.x; o.y = v.y < 0.f ? m.y : r.y; return o;
}

template <int ACT  > struct EpiBf16 {
    static constexpr bool PERM = true, AFTER_DRAIN = false; static_assert(ACT == 0 || ACT == 1, "EpiBf16: ACT is 0 (none) or 1 (gelu_pk)");
    bf16_t* O; int ldc; const float* bias; int split_cols; size_t split_stride; float scale0;
    __device__ __forceinline__ void operator()(const f32x4 (&acc)[2][2][4][2], const Unit& u, int wr, int wc, int fr, int fq) const {
        const int row0 = u.pm * BM + wr * 64 + fr; int colt = u.pn * BM; bf16_t* base = O;
        float sc = 1.f; if (split_cols) { const int t = colt / split_cols; base += (size_t)t * split_stride; colt -= t * split_cols; if (t == 0) sc = scale0; }
        const int col0 = colt + wc * 32 + 8 * fq, bcol0 = u.pn * BM + wc * 32 + 8 * fq;
        f32x4 bv[2][2];
#pragma unroll
        for (int bj = 0; bj < 2; ++bj)
#pragma unroll
            for (int n = 0; n < 2; ++n) bv[bj][n] = bias ? *(const f32x4*)(bias + bcol0 + bj * HALF + 4 * n) : (f32x4){0.f, 0.f, 0.f, 0.f};
#pragma unroll
        for (int ai = 0; ai < 2; ++ai)
#pragma unroll
            for (int m = 0; m < 4; ++m) { bf16_t* rowp = base + (size_t)(row0 + ai * HALF + m * 16) * ldc + col0;
#pragma unroll
                for (int bj = 0; bj < 2; ++bj) { f32x4 v0 = acc[ai][bj][m][0] + bv[bj][0], v1 = acc[ai][bj][m][1] + bv[bj][1];
                    if (ACT == 1) { f32x2 a = gelu_pk((f32x2){v0[0], v0[1]}), b = gelu_pk((f32x2){v0[2], v0[3]}), c = gelu_pk((f32x2){v1[0], v1[1]}), d = gelu_pk((f32x2){v1[2], v1[3]});
                        v0 = (f32x4){a.x, a.y, b.x, b.y}; v1 = (f32x4){c.x, c.y, d.x, d.y}; }
                    v0 = v0 * sc; v1 = v1 * sc; u32x4 w; w.x = cvt_pk_bf16(v0[0], v0[1]); w.y = cvt_pk_bf16(v0[2], v0[3]); w.z = cvt_pk_bf16(v1[0], v1[1]); w.w = cvt_pk_bf16(v1[2], v1[3]);
                    *(u32x4*)(rowp + bj * HALF) = w; } }
    }
};

struct PanelStats {
    unsigned* xbuf;
    unsigned* cnt;
    unsigned* tmo;
    int ntn; float eps;
    unsigned code;
    __device__ __forceinline__ bool run(const f32x4 (&v)[2][2][4][2], const Unit& u, int wr, int wc, int fr, int fq, PG8_LAS unsigned char* lds, int wid, int lane) const {
        typedef float f32x2v __attribute__((ext_vector_type(2)));
        PG8_LAS f32x2v* P = (PG8_LAS f32x2v*)lds;
        PG8_LAS f32x2v* S = (PG8_LAS f32x2v*)(lds + 8192);
        PG8_LAS unsigned* flag = (PG8_LAS unsigned*)(lds + 8192 + 2048);
#pragma unroll
        for (int ai = 0; ai < 2; ++ai)
#pragma unroll
            for (int m = 0; m < 4; ++m) {
                float s = 0.f;
#pragma unroll
                for (int bj = 0; bj < 2; ++bj)
#pragma unroll
                    for (int n = 0; n < 2; ++n) { const f32x4 x = v[ai][bj][m][n]; s += (x[0] + x[1]) + (x[2] + x[3]); }
                s += __shfl_xor(s, 16); s += __shfl_xor(s, 32);
                const float mw = s * (1.0f / 64.0f); float q = 0.f;
#pragma unroll
                for (int bj = 0; bj < 2; ++bj)
#pragma unroll
                    for (int n = 0; n < 2; ++n) { const f32x4 d = v[ai][bj][m][n] - mw; q += (d[0] * d[0] + d[1] * d[1]) + (d[2] * d[2] + d[3] * d[3]); }
                q += __shfl_xor(q, 16); q += __shfl_xor(q, 32);
                if (fq == 0) P[(ai * HALF + wr * 64 + m * 16 + fr) * 4 + wc] = (f32x2v){mw, q};
            }
        asm volatile("s_waitcnt lgkmcnt(0)" ::: "memory"); __builtin_amdgcn_s_barrier(); asm volatile("" ::: "memory");
#if defined(BROKEN_EXCHANGE_NO_WAIT)
#warning BROKEN CONTROL BUILD: the row-statistics exchange does not wait; results are wrong by design
        if (blockIdx.x >= 64) { const long long t0_ = clock64(); while (clock64() - t0_ < 60000) __builtin_amdgcn_s_sleep(8); }
#endif
        const int row = wid * 32 + (lane & 31);
        if (lane < 32) {
            const f32x2v a = P[row * 4 + 0], b = P[row * 4 + 1], c = P[row * 4 + 2], d = P[row * 4 + 3];
            const float mt = (a.x + b.x + c.x + d.x) * 0.25f;
            const float da = a.x - mt, db = b.x - mt, dc = c.x - mt, dd = d.x - mt;
            const float m2 = (a.y + b.y) + (c.y + d.y) + 64.0f * ((da * da + db * db) + (dc * dc + dd * dd));
            unsigned long long* slot = (unsigned long long*)xbuf + ((size_t)(u.pm * BM + row) * 4 + u.pn);
            __hip_atomic_store(slot, ((unsigned long long)__float_as_uint(m2) << 32) | __float_as_uint(mt), __ATOMIC_RELAXED, __HIP_MEMORY_SCOPE_AGENT);
        }
        asm volatile("s_waitcnt vmcnt(0)" ::: "memory");
        if (lane == 0) __hip_atomic_fetch_add(cnt + 64 * u.pm, 1u, __ATOMIC_RELAXED, __HIP_MEMORY_SCOPE_AGENT);
        if (wid == 0) {
            bool dead = false; const unsigned long long t0 = __builtin_amdgcn_s_memrealtime(); const unsigned want = 8u * (unsigned)ntn;
            for (;;) {
#if defined(BROKEN_EXCHANGE_NO_WAIT)
                break;
#endif
                if ((unsigned)__builtin_amdgcn_readfirstlane(__hip_atomic_load(cnt + 64 * u.pm, __ATOMIC_RELAXED, __HIP_MEMORY_SCOPE_AGENT)) >= want) break;
                if (__builtin_amdgcn_s_memrealtime() - t0 > 2000000ull) {
                    if (lane == 0) { unsigned expect = 0u; __hip_atomic_compare_exchange_strong(tmo + 1, &expect, code | (unsigned)(u.pm & 0xff), __ATOMIC_RELAXED, __ATOMIC_RELAXED, __HIP_MEMORY_SCOPE_AGENT);
                                     __hip_atomic_store(tmo, 1u, __ATOMIC_RELAXED, __HIP_MEMORY_SCOPE_AGENT); }
                    dead = true; break; }
                __builtin_amdgcn_s_sleep(2);
            }
            __builtin_amdgcn_fence(__ATOMIC_ACQUIRE, "agent");
            if (lane == 0) flag[0] = dead ? 1u : 0u;
        }
        asm volatile("s_waitcnt vmcnt(0) lgkmcnt(0)" ::: "memory"); __builtin_amdgcn_s_barrier(); asm volatile("" ::: "memory");
        const bool bad = flag[0] != 0u;
        if (lane < 32) {
            const unsigned long long* slot = (const unsigned long long*)xbuf + (size_t)(u.pm * BM + row) * 4; float mt[4], m2[4]; float ms = 0.f;
#pragma unroll
            for (int t = 0; t < 4; ++t) { if (t < ntn) { const unsigned long long w = __hip_atomic_load(slot + t, __ATOMIC_RELAXED, __HIP_MEMORY_SCOPE_AGENT); mt[t] = __uint_as_float((unsigned)w); m2[t] = __uint_as_float((unsigned)(w >> 32)); } else { mt[t] = 0.f; m2[t] = 0.f; } ms += mt[t]; }
            const float mean = ms / (float)ntn; float q = 0.f;
#pragma unroll
            for (int t = 0; t < 4; ++t) if (t < ntn) { const float dm = mt[t] - mean; q += m2[t] + 256.0f * dm * dm; }
            S[row] = (f32x2v){mean, 1.0f / sqrtf(q / (256.0f * (float)ntn) + eps)};
        }
        asm volatile("s_waitcnt lgkmcnt(0)" ::: "memory"); __builtin_amdgcn_s_barrier(); asm volatile("" ::: "memory");
        return bad;
    }
};
struct EpiLnRes {
    static constexpr bool PERM = false, AFTER_DRAIN = true;
    const float* base; float* out; int ldc; const float* bias; PanelStats st; unsigned poison;
    __device__ __forceinline__ void fused(f32x4 (&acc)[2][2][4][2], const Unit& u, int wr, int wc, int fr, int fq, PG8_LAS unsigned char* lds, int wid, int lane) const {
        typedef float f32x2v __attribute__((ext_vector_type(2)));
        const PG8_LAS f32x2v* S = (const PG8_LAS f32x2v*)(lds + 8192);
        const int col0 = u.pn * BM + wc * 32 + 4 * fq;
#pragma unroll
        for (int bj = 0; bj < 2; ++bj)
#pragma unroll
            for (int n = 0; n < 2; ++n) { const f32x4 bv = bias ? *(const f32x4*)(bias + col0 + bj * HALF + n * 16) : (f32x4){0.f, 0.f, 0.f, 0.f};
#pragma unroll
                for (int ai = 0; ai < 2; ++ai)
#pragma unroll
                    for (int m = 0; m < 4; ++m) acc[ai][bj][m][n] += bv; }
        f32x4 pre[4][2][2];
#pragma unroll
        for (int m = 0; m < 4; ++m) { const size_t off = (size_t)(u.pm * BM + wr * 64 + m * 16 + fr) * ldc + col0;
#pragma unroll
            for (int bj = 0; bj < 2; ++bj)
#pragma unroll
                for (int n = 0; n < 2; ++n) pre[m][bj][n] = *(const f32x4*)(base + off + bj * HALF + n * 16); }
        const bool bad = st.run(acc, u, wr, wc, fr, fq, lds, wid, lane) || poison != 0u;
        const float qnan = __builtin_nanf("");
#pragma unroll
        for (int ai = 0; ai < 2; ++ai)
#pragma unroll
            for (int m = 0; m < 4; ++m) { const int r = ai * HALF + wr * 64 + m * 16 + fr; const f32x2v sr = S[r]; const size_t off = (size_t)(u.pm * BM + r) * ldc + col0;
#pragma unroll
                for (int bj = 0; bj < 2; ++bj)
#pragma unroll
                    for (int n = 0; n < 2; ++n) { const f32x4 bs = ai == 0 ? pre[m][bj][n] : *(const f32x4*)(base + off + bj * HALF + n * 16); f32x4 o = bs + (acc[ai][bj][m][n] - sr.x) * sr.y;
                        if (bad) o = (f32x4){qnan, qnan, qnan, qnan}; *(f32x4*)(out + off + bj * HALF + n * 16) = o; }
                if (m & 1) asm volatile("" ::: "memory"); }
    }
};
struct EpiLnResLn {
    static constexpr bool PERM = false, AFTER_DRAIN = true;
    const float* base; float* out; bf16_t* xn; int ldc; const float* bias; PanelStats st1, st2; unsigned poison;
    __device__ __forceinline__ void fused(f32x4 (&acc)[2][2][4][2], const Unit& u, int wr, int wc, int fr, int fq, PG8_LAS unsigned char* lds, int wid, int lane) const {
        typedef float f32x2v __attribute__((ext_vector_type(2))); typedef unsigned u32x2v __attribute__((ext_vector_type(2)));
        const PG8_LAS f32x2v* S = (const PG8_LAS f32x2v*)(lds + 8192);
        const int col0 = u.pn * BM + wc * 32 + 4 * fq;
#pragma unroll
        for (int bj = 0; bj < 2; ++bj)
#pragma unroll
            for (int n = 0; n < 2; ++n) { const f32x4 bv = bias ? *(const f32x4*)(bias + col0 + bj * HALF + n * 16) : (f32x4){0.f, 0.f, 0.f, 0.f};
#pragma unroll
                for (int ai = 0; ai < 2; ++ai)
#pragma unroll
                    for (int m = 0; m < 4; ++m) acc[ai][bj][m][n] += bv; }
        bool bad = st1.run(acc, u, wr, wc, fr, fq, lds, wid, lane) || poison != 0u;
        const float qnan = __builtin_nanf("");
#pragma unroll
        for (int ai = 0; ai < 2; ++ai)
#pragma unroll
            for (int m = 0; m < 4; ++m) { const int r = ai * HALF + wr * 64 + m * 16 + fr; const f32x2v sr = S[r]; const size_t off = (size_t)(u.pm * BM + r) * ldc + col0;
#pragma unroll
                for (int bj = 0; bj < 2; ++bj)
#pragma unroll
                    for (int n = 0; n < 2; ++n) { const f32x4 bs = *(const f32x4*)(base + off + bj * HALF + n * 16); acc[ai][bj][m][n] = bs + (acc[ai][bj][m][n] - sr.x) * sr.y; }
                asm volatile("" : "+v"(acc[ai][0][m][0]), "+v"(acc[ai][0][m][1]), "+v"(acc[ai][1][m][0]), "+v"(acc[ai][1][m][1]));
                if (m & 1) asm volatile("" ::: "memory"); }
        const bool bad1 = bad;
        bad = st2.run(acc, u, wr, wc, fr, fq, lds, wid, lane) || bad;
#pragma unroll
        for (int ai = 0; ai < 2; ++ai)
#pragma unroll
            for (int m = 0; m < 4; ++m) { const int r = ai * HALF + wr * 64 + m * 16 + fr; const f32x2v sr = S[r]; const size_t off = (size_t)(u.pm * BM + r) * ldc + col0;
#pragma unroll
                for (int bj = 0; bj < 2; ++bj)
#pragma unroll
                    for (int n = 0; n < 2; ++n) { const f32x4 x1 = acc[ai][bj][m][n]; *(f32x4*)(out + off + bj * HALF + n * 16) = bad1 ? (f32x4){qnan, qnan, qnan, qnan} : x1;
                        const f32x4 o = (x1 - sr.x) * sr.y; u32x2v w; w.x = cvt_pk_bf16(o[0], o[1]); w.y = cvt_pk_bf16(o[2], o[3]);
                        if (bad) { w.x = 0x7fc07fc0u; w.y = 0x7fc07fc0u; } *(u32x2v*)(xn + off + bj * HALF + n * 16) = w; }
                asm volatile("" ::: "memory"); }
    }
};

template <class Epi, class Sched, bool ALIGN_EPI = false, bool SP2 = false>
__device__ __forceinline__ void gemm_phase(PG8_LAS unsigned char* lds, const Gemm g, const Sched& S, const Epi& E) {
    const int tid = threadIdx.x, wid = __builtin_amdgcn_readfirstlane(tid >> 6), lane = tid & 63, wr = wid >> 2, wc = wid & 3, fr = lane & 15, fq = lane >> 4;
    const int K = g.ld ? g.ld : g.K, nt = g.K / BK;
    unsigned voffA[2], voffB[2];
#pragma unroll
    for (int i = 0; i < 2; ++i) { int R, C; stage_rc(tid * 16 + i * 8192, R, C); const int Rb = Epi::PERM ? ((R & ~31) + perm32(R & 31)) : R;
        voffA[i] = (unsigned)(R * K + C) * 2u; voffB[i] = (unsigned)(Rb * K + C) * 2u; }
    const size_t kstep = (size_t)(BK * 2);
    const size_t hstep = (size_t)HALF * K * 2;
    const size_t tstep = 2 * hstep;
    const unsigned ldsw = (unsigned)wid * 1024u;
    const int aoff = lds_byte(wr * 64 + fr, fq * 8), boff = lds_byte(wc * 32 + fr, fq * 8);
#define PG8_SA(b, h) (((b) * 2 + (h)) * HTB)
#define PG8_SB(b, h) ((4 + (b) * 2 + (h)) * HTB)
#define PG8_STAGE(bufoff, gbase, voff) do { _Pragma("unroll") for (int _i = 0; _i < 2; ++_i) \
        __builtin_amdgcn_global_load_lds((const unsigned*)((const char*)(gbase) + (voff)[_i]), (PG8_LAS unsigned*)(lds + (bufoff) + ldsw + _i * 8192), 16, 0, 0); } while (0)
#define PG8_LDA(dst, b, h) do { _Pragma("unroll") for (int m = 0; m < 4; ++m) _Pragma("unroll") for (int k = 0; k < 2; ++k) dst[m][k] = *(const PG8_LAS bf16x8*)(lds + PG8_SA(b, h) + aoff + m * 2048 + k * 1024); } while (0)
#define PG8_LDB(dst, b, h) do { _Pragma("unroll") for (int n = 0; n < 2; ++n) _Pragma("unroll") for (int k = 0; k < 2; ++k) dst[n][k] = *(const PG8_LAS bf16x8*)(lds + PG8_SB(b, h) + boff + n * 2048 + k * 1024); } while (0)
#define PG8_MMA(ai, bj, At, Bt) do { __builtin_amdgcn_s_setprio(1); _Pragma("unroll") for (int m = 0; m < 4; ++m) _Pragma("unroll") for (int n = 0; n < 2; ++n) _Pragma("unroll") for (int k = 0; k < 2; ++k) \
        acc[ai][bj][m][n] = __builtin_amdgcn_mfma_f32_16x16x32_bf16(Bt[n][k], At[m][k], acc[ai][bj][m][n], 0, 0, 0); __builtin_amdgcn_s_setprio(0); } while (0)
#define PG8_WAIT_V(n) asm volatile("s_waitcnt vmcnt(" #n ")" ::: "memory")
#define PG8_WAIT_L(n) asm volatile("s_waitcnt lgkmcnt(" #n ")" ::: "memory")
#define PG8_BAR __builtin_amdgcn_s_barrier()
#define PG8_SCHED __builtin_amdgcn_sched_barrier(0)
    Unit cur, nxt; int ui = 0;
    if (!S.next(0, cur)) return;
    f32x4 acc[2][2][4][2];
#pragma unroll
    for (int a = 0; a < 2; ++a)
#pragma unroll
        for (int b = 0; b < 2; ++b)
#pragma unroll
            for (int m = 0; m < 4; ++m)
#pragma unroll
                for (int n = 0; n < 2; ++n) acc[a][b][m][n] = (f32x4){0.f, 0.f, 0.f, 0.f};
    bf16x8 At[4][2], B0[2][2], B1[2][2];
    const char* cA = (const char*)g.A + (size_t)cur.pm * tstep + (size_t)cur.k0 * 2; const char* cB = (const char*)g.Bt + (size_t)cur.pn * tstep + (size_t)cur.k0 * 2;
    S.a_ready(cur);
    if constexpr (SP2) {
        PG8_STAGE(PG8_SB(0, 0), cB, voffB); PG8_STAGE(PG8_SB(0, 1), cB + hstep, voffB); PG8_STAGE(PG8_SA(0, 0), cA, voffA); PG8_STAGE(PG8_SA(0, 1), cA + hstep, voffA);
        if (wr == 1) PG8_BAR;
        PG8_WAIT_V(2); PG8_BAR;
        PG8_STAGE(PG8_SB(1, 0), cB + kstep, voffB); PG8_STAGE(PG8_SA(1, 0), cA + kstep, voffA); PG8_STAGE(PG8_SB(1, 1), cB + hstep + kstep, voffB);
        PG8_WAIT_V(6); PG8_BAR;
    } else {
        PG8_STAGE(PG8_SB(0, 0), cB, voffB); PG8_STAGE(PG8_SA(0, 0), cA, voffA); PG8_STAGE(PG8_SB(0, 1), cB + hstep, voffB); PG8_STAGE(PG8_SA(0, 1), cA + hstep, voffA);
        if (wr == 1) PG8_BAR;
        PG8_WAIT_V(4); PG8_BAR;
        PG8_STAGE(PG8_SB(1, 0), cB + kstep, voffB); PG8_STAGE(PG8_SA(1, 0), cA + kstep, voffA); PG8_STAGE(PG8_SB(1, 1), cB + hstep + kstep, voffB);
        PG8_WAIT_V(6); PG8_BAR;
    }
    for (;;) {
        const bool has_next = S.next(ui + 1, nxt);
        const char* nA = has_next ? (const char*)g.A + (size_t)nxt.pm * tstep + (size_t)nxt.k0 * 2 : cA; const char* nB = has_next ? (const char*)g.Bt + (size_t)nxt.pn * tstep + (size_t)nxt.k0 * 2 : cB;
        for (int t = 0; t < nt; t += 2) {
            const bool last = (t == nt - 2);
            const char* a1 = cA + (size_t)(t + 1) * kstep;
            const char* a2 = last ? nA : cA + (size_t)(t + 2) * kstep; const char* b2 = last ? nB : cB + (size_t)(t + 2) * kstep;
            const char* a3 = a2 + kstep; const char* b3 = b2 + kstep;
            if (last && has_next) S.a_ready(nxt);
            if constexpr (SP2) {
            PG8_LDB(B0, 0, 0); PG8_LDB(B1, 0, 1); PG8_SCHED; PG8_LDA(At, 0, 0); PG8_STAGE(PG8_SA(1, 1), a1 + hstep, voffA);
            PG8_WAIT_V(8); PG8_WAIT_L(0); PG8_BAR; PG8_MMA(0, 0, At, B0); PG8_MMA(0, 1, At, B1); PG8_BAR; PG8_SCHED;
            PG8_LDA(At, 0, 1); PG8_STAGE(PG8_SB(0, 0), b2, voffB); PG8_STAGE(PG8_SB(0, 1), b2 + hstep, voffB); PG8_STAGE(PG8_SA(0, 0), a2, voffA);
            PG8_WAIT_V(8); PG8_WAIT_L(0); PG8_BAR; PG8_MMA(1, 0, At, B0); PG8_MMA(1, 1, At, B1); PG8_BAR; PG8_SCHED;
            PG8_LDB(B0, 1, 0); PG8_LDB(B1, 1, 1); PG8_SCHED; PG8_LDA(At, 1, 0); PG8_STAGE(PG8_SA(0, 1), a2 + hstep, voffA);
            PG8_WAIT_V(8); PG8_WAIT_L(0); PG8_BAR; PG8_MMA(0, 0, At, B0); PG8_MMA(0, 1, At, B1); PG8_BAR; PG8_SCHED;
            PG8_LDA(At, 1, 1); PG8_STAGE(PG8_SB(1, 0), b3, voffB); PG8_STAGE(PG8_SB(1, 1), b3 + hstep, voffB); PG8_STAGE(PG8_SA(1, 0), a3, voffA);
            PG8_WAIT_V(8); PG8_WAIT_L(0); PG8_BAR; PG8_MMA(1, 0, At, B0); PG8_MMA(1, 1, At, B1); PG8_BAR; PG8_SCHED;
            } else {
            PG8_LDB(B0, 0, 0); PG8_SCHED; PG8_LDA(At, 0, 0); PG8_STAGE(PG8_SA(1, 1), a1 + hstep, voffA);
            PG8_WAIT_L(8); PG8_BAR; PG8_WAIT_L(0); PG8_MMA(0, 0, At, B0); PG8_BAR; PG8_SCHED;
            PG8_LDB(B1, 0, 1); PG8_STAGE(PG8_SB(0, 0), b2, voffB);
            PG8_BAR; PG8_WAIT_L(0); PG8_MMA(0, 1, At, B1); PG8_BAR;
            PG8_LDA(At, 0, 1); PG8_STAGE(PG8_SA(0, 0), a2, voffA);
            PG8_BAR; PG8_WAIT_L(0); PG8_MMA(1, 0, At, B0); PG8_BAR; PG8_SCHED;
            PG8_STAGE(PG8_SB(0, 1), b2 + hstep, voffB);
            PG8_WAIT_V(6); PG8_BAR; PG8_MMA(1, 1, At, B1); PG8_BAR;
            PG8_LDB(B0, 1, 0); PG8_SCHED; PG8_LDA(At, 1, 0); PG8_STAGE(PG8_SA(0, 1), a2 + hstep, voffA);
            PG8_WAIT_L(8); PG8_BAR; PG8_WAIT_L(0); PG8_MMA(0, 0, At, B0); PG8_BAR; PG8_SCHED;
            PG8_LDB(B1, 1, 1); PG8_STAGE(PG8_SB(1, 0), b3, voffB);
            PG8_BAR; PG8_WAIT_L(0); PG8_MMA(0, 1, At, B1); PG8_BAR;
            PG8_LDA(At, 1, 1); PG8_STAGE(PG8_SA(1, 0), a3, voffA);
            PG8_BAR; PG8_WAIT_L(0); PG8_MMA(1, 0, At, B0); PG8_BAR; PG8_SCHED;
            PG8_STAGE(PG8_SB(1, 1), b3 + hstep, voffB);
            PG8_WAIT_V(6); PG8_BAR; PG8_MMA(1, 1, At, B1); PG8_BAR;
            }
        }
        if constexpr (ALIGN_EPI) { if (wr == 0) PG8_BAR; }
        if constexpr (!Epi::AFTER_DRAIN) { E(acc, cur, wr, wc, fr, fq); S.done(cur); }
        if (!has_next) break;
#pragma unroll
        for (int a = 0; a < 2; ++a)
#pragma unroll
            for (int b = 0; b < 2; ++b)
#pragma unroll
                for (int m = 0; m < 4; ++m)
#pragma unroll
                    for (int n = 0; n < 2; ++n) acc[a][b][m][n] = (f32x4){0.f, 0.f, 0.f, 0.f};
        cur = nxt; cA = nA; cB = nB; ++ui;
        if constexpr (ALIGN_EPI) { if (wr == 1) PG8_BAR; }
    }
    PG8_WAIT_V(0);
    if constexpr (!ALIGN_EPI) { if (wr == 0) PG8_BAR; }
    PG8_BAR;
    if constexpr (Epi::AFTER_DRAIN) { E.fused(acc, cur, wr, wc, fr, fq, lds, wid, lane); S.done(cur); }
#undef PG8_SA
#undef PG8_SB
#undef PG8_STAGE
#undef PG8_LDA
#undef PG8_LDB
#undef PG8_MMA
#undef PG8_WAIT_V
#undef PG8_WAIT_L
#undef PG8_BAR
#undef PG8_SCHED
}
}


__device__ __forceinline__ float xl_dpp_b1(float x) { return __uint_as_float((unsigned)__builtin_amdgcn_update_dpp(0, (int)__float_as_uint(x), 0xB1, 0xF, 0xF, true)); }
__device__ __forceinline__ float xl_dpp_4e(float x) { return __uint_as_float((unsigned)__builtin_amdgcn_update_dpp(0, (int)__float_as_uint(x), 0x4E, 0xF, 0xF, true)); }
__device__ __forceinline__ float xl_mir8(float x)   { return __uint_as_float((unsigned)__builtin_amdgcn_update_dpp(0, (int)__float_as_uint(x), 0x141, 0xF, 0xF, true)); }
__device__ __forceinline__ float xl_mir16(float x)  { return __uint_as_float((unsigned)__builtin_amdgcn_update_dpp(0, (int)__float_as_uint(x), 0x140, 0xF, 0xF, true)); }
__device__ __forceinline__ float xl_xor16(float x) { const auto rr = __builtin_amdgcn_permlane16_swap(__float_as_uint(x), __float_as_uint(x), false, false); return __uint_as_float((threadIdx.x & 16) ? rr[0] : rr[1]); }
__device__ __forceinline__ float xl_xor32(float x) { const auto rr = __builtin_amdgcn_permlane32_swap(__float_as_uint(x), __float_as_uint(x), false, false); return __uint_as_float((threadIdx.x & 32) ? rr[0] : rr[1]); }
namespace pg8 {
typedef unsigned u32x2 __attribute__((ext_vector_type(2)));
__device__ __forceinline__ float bflo(unsigned w) { return __uint_as_float(w << 16); }
__device__ __forceinline__ float bfhi(unsigned w) { return __uint_as_float(w & 0xffff0000u); }
__device__ __forceinline__ float silu_f(float x) { return x * __builtin_amdgcn_rcpf(1.0f + __expf(-x)); }
__device__ __forceinline__ float sigm_f(float x) { return __builtin_amdgcn_rcpf(1.0f + __expf(-x)); }

struct EpiSwiglu {
    static constexpr bool PERM = true, AFTER_DRAIN = false;
    bf16_t* O; int ldc; const float* rs;
    __device__ __forceinline__ void operator()(const f32x4 (&acc)[2][2][4][2], const Unit& u, int wr, int wc, int fr, int fq) const {
        const int row0 = u.pm * BM + wr * 64 + fr, col0 = u.pn * HALF + wc * 32 + 8 * fq;
        const __amdgpu_buffer_rsrc_t rsrc = __builtin_amdgcn_make_buffer_rsrc(O, 0, 33280 * 2816 * 2, 0x00020000);
        float rsv[2][4];
#pragma unroll
        for (int ai = 0; ai < 2; ++ai)
#pragma unroll
            for (int m = 0; m < 4; ++m) rsv[ai][m] = rs[row0 + ai * HALF + m * 16];
#pragma unroll
        for (int ai = 0; ai < 2; ++ai)
#pragma unroll
            for (int m = 0; m < 4; ++m) {
                const unsigned boff = (unsigned)(((row0 + ai * HALF + m * 16) * ldc + col0) * 2);
                const float rr = rsv[ai][m];
                const f32x4 g0 = acc[ai][0][m][0] * rr, g1 = acc[ai][0][m][1] * rr, u0 = acc[ai][1][m][0] * rr, u1 = acc[ai][1][m][1] * rr;
                u32x4 w;
                w.x = cvt_pk_bf16(silu_f(g0[0]) * u0[0], silu_f(g0[1]) * u0[1]); w.y = cvt_pk_bf16(silu_f(g0[2]) * u0[2], silu_f(g0[3]) * u0[3]);
                w.z = cvt_pk_bf16(silu_f(g1[0]) * u1[0], silu_f(g1[1]) * u1[1]); w.w = cvt_pk_bf16(silu_f(g1[2]) * u1[2], silu_f(g1[3]) * u1[3]);
                __builtin_amdgcn_raw_buffer_store_b128(w, rsrc, boff, 0, 16);
            }
    }
};
struct EpiPlain {
    static constexpr bool PERM = true, AFTER_DRAIN = false;
    bf16_t* O; int ldc; const float* rs;
    __device__ __forceinline__ void operator()(const f32x4 (&acc)[2][2][4][2], const Unit& u, int wr, int wc, int fr, int fq) const {
        const int row0 = u.pm * BM + wr * 64 + fr, col0 = u.pn * BM + wc * 32 + 8 * fq;
        float rsv[2][4];
#pragma unroll
        for (int ai = 0; ai < 2; ++ai)
#pragma unroll
            for (int m = 0; m < 4; ++m) rsv[ai][m] = rs[row0 + ai * HALF + m * 16];
#pragma unroll
        for (int ai = 0; ai < 2; ++ai)
#pragma unroll
            for (int m = 0; m < 4; ++m) {
                bf16_t* rowp = O + (size_t)(row0 + ai * HALF + m * 16) * ldc + col0;
                const float rr = rsv[ai][m];
#pragma unroll
                for (int bj = 0; bj < 2; ++bj) { const f32x4 v0 = acc[ai][bj][m][0] * rr, v1 = acc[ai][bj][m][1] * rr; u32x4 w;
                    w.x = cvt_pk_bf16(v0[0], v0[1]); w.y = cvt_pk_bf16(v0[2], v0[3]); w.z = cvt_pk_bf16(v1[0], v1[1]); w.w = cvt_pk_bf16(v1[2], v1[3]);
                    *(u32x4*)(rowp + bj * HALF) = w; }
            }
    }
};
struct EpiWin {
    static constexpr bool PERM = true, AFTER_DRAIN = false;
    bf16_t* Z; const float2* rope; const float* rs;
    __device__ __forceinline__ void operator()(const f32x4 (&acc)[2][2][4][2], const Unit& u, int wr, int wc, int fr, int fq) const {
        const int row0 = u.pm * BM + wr * 64 + fr, col0 = u.pn * BM + wc * 32 + 8 * fq;
        float rsv[2][4];
#pragma unroll
        for (int ai = 0; ai < 2; ++ai)
#pragma unroll
            for (int m = 0; m < 4; ++m) rsv[ai][m] = rs[row0 + ai * HALF + m * 16];
#pragma unroll
        for (int ai = 0; ai < 2; ++ai)
#pragma unroll
            for (int m = 0; m < 4; ++m) {
                const int row = row0 + ai * HALF + m * 16;
                const int pidx = row < 32768 ? (row & 8191) : 8192 + ((row - 32768) & 3);
                bf16_t* rowp = Z + (size_t)row * 1280 + col0;
                const float rr = rsv[ai][m];
#pragma unroll
                for (int bj = 0; bj < 2; ++bj) {
                    f32x4 v[2] = {acc[ai][bj][m][0] * rr, acc[ai][bj][m][1] * rr};
                    const bool dorope = ((u.pn == 2) || (u.pn == 3) || (u.pn == 4 && bj == 0)) && ((wc & 1) == 0);
                    if (dorope) {
#pragma unroll
                        for (int n = 0; n < 2; ++n)
#pragma unroll
                            for (int e = 0; e < 4; ++e) {
                                const float x = v[n][e]; const float p = xl_xor16(x);
                                const float2 cs = rope[pidx * 8 + 4 * n + e];
                                const float r0 = x * cs.x - p * cs.y, r1 = x * cs.x + p * cs.y;
                                v[n][e] = fq == 0 ? r0 : (fq == 1 ? r1 : x);
                            }
                    }
                    u32x4 w; w.x = cvt_pk_bf16(v[0][0], v[0][1]); w.y = cvt_pk_bf16(v[0][2], v[0][3]); w.z = cvt_pk_bf16(v[1][0], v[1][1]); w.w = cvt_pk_bf16(v[1][2], v[1][3]);
                    *(u32x4*)(rowp + bj * HALF) = w;
                }
            }
    }
};
struct EpiGlu {
    static constexpr bool PERM = true, AFTER_DRAIN = false;
    const bf16_t* G; const float* bias; bf16_t* O; int ldo; unsigned* cnt;
    __device__ __forceinline__ void operator()(const f32x4 (&acc)[2][2][4][2], const Unit& u, int wr, int wc, int fr, int fq) const {
        const int row0 = u.pm * BM + wr * 64 + fr, col0 = u.pn * BM + wc * 32 + 8 * fq;
        const __amdgpu_buffer_rsrc_t rsrc = __builtin_amdgcn_make_buffer_rsrc(O, 0, 33280 * 1024 * 2, 0x00020000);
#pragma unroll
        for (int ai = 0; ai < 2; ++ai)
#pragma unroll
            for (int m = 0; m < 4; ++m) {
                const int row = row0 + ai * HALF + m * 16;
#pragma unroll
                for (int bj = 0; bj < 2; ++bj) {
                    const int col = col0 + bj * HALF;
                    const u32x4 gv = *(const u32x4*)(G + (size_t)row * 512 + col);
                    const f32x4 b0 = *(const f32x4*)(bias + col), b1 = *(const f32x4*)(bias + col + 4);
                    const f32x4 v0 = acc[ai][bj][m][0] + b0, v1 = acc[ai][bj][m][1] + b1;
                    u32x4 w;
                    w.x = cvt_pk_bf16(bflo(gv.x) * sigm_f(v0[0]), bfhi(gv.x) * sigm_f(v0[1])); w.y = cvt_pk_bf16(bflo(gv.y) * sigm_f(v0[2]), bfhi(gv.y) * sigm_f(v0[3]));
                    w.z = cvt_pk_bf16(bflo(gv.z) * sigm_f(v1[0]), bfhi(gv.z) * sigm_f(v1[1])); w.w = cvt_pk_bf16(bflo(gv.w) * sigm_f(v1[2]), bfhi(gv.w) * sigm_f(v1[3]));
                    __builtin_amdgcn_raw_buffer_store_b128(w, rsrc, (unsigned)((row * ldo + col) * 2), 0, 16);
                }
            }
        asm volatile("s_waitcnt vmcnt(0)" ::: "memory");
        __builtin_amdgcn_s_barrier();
        if (threadIdx.x == 0) __hip_atomic_fetch_add(cnt + 64 * u.pm, 1u, __ATOMIC_RELAXED, __HIP_MEMORY_SCOPE_AGENT);
    }
};
struct PanelOrder2 {
    int vc;
    __device__ bool next(int i, Unit& u) const { if (i > 0) return false; u.pm = vc >> 1; u.pn = vc & 1; u.k0 = 0; return true; }
    __device__ __forceinline__ void a_ready(const Unit&) const {}
    __device__ __forceinline__ void done(const Unit&) const {}
};
struct EpiMemKV {
    static constexpr bool PERM = true, AFTER_DRAIN = false;
    float* OKp; float* OVp; bf16_t* MK; bf16_t* MVT;
    __device__ __forceinline__ void operator()(const f32x4 (&acc)[2][2][4][2], const Unit& u, int wr, int wc, int fr, int fq) const {
        const int row0 = u.pm * BM + wr * 64 + fr, col0 = u.pn * BM + wc * 32 + 8 * fq;
#pragma unroll
        for (int ai = 0; ai < 2; ++ai)
#pragma unroll
            for (int m = 0; m < 4; ++m) {
                const int row = row0 + ai * HALF + m * 16;
#pragma unroll
                for (int bj = 0; bj < 2; ++bj) {
                    const int col = col0 + bj * HALF;
                    const f32x4 v0 = acc[ai][bj][m][0], v1 = acc[ai][bj][m][1];
                    if (u.pn < 4) {
                        *(f32x4*)(OKp + (size_t)row * 1024 + col) = v0; *(f32x4*)(OKp + (size_t)row * 1024 + col + 4) = v1;
                        u32x4 w; w.x = cvt_pk_bf16(v0[0], v0[1]); w.y = cvt_pk_bf16(v0[2], v0[3]); w.z = cvt_pk_bf16(v1[0], v1[1]); w.w = cvt_pk_bf16(v1[2], v1[3]);
                        *(u32x4*)(MK + (size_t)row * 1024 + col) = w;
                    } else {
                        const int cv = col - 1024;
                        *(f32x4*)(OVp + (size_t)row * 1024 + cv) = v0; *(f32x4*)(OVp + (size_t)row * 1024 + cv + 4) = v1;
                        const int b = row >> 8, mt = row & 255;
                        bf16_t* vt = MVT + ((size_t)(b * 1024 + cv) * 256 + mt);
                        const unsigned w0 = cvt_pk_bf16(v0[0], v0[1]), w1 = cvt_pk_bf16(v0[2], v0[3]), w2 = cvt_pk_bf16(v1[0], v1[1]), w3 = cvt_pk_bf16(v1[2], v1[3]);
                        vt[0 * 256] = (bf16_t)w0; vt[1 * 256] = (bf16_t)(w0 >> 16); vt[2 * 256] = (bf16_t)w1; vt[3 * 256] = (bf16_t)(w1 >> 16);
                        vt[4 * 256] = (bf16_t)w2; vt[5 * 256] = (bf16_t)(w2 >> 16); vt[6 * 256] = (bf16_t)w3; vt[7 * 256] = (bf16_t)(w3 >> 16);
                    }
                }
            }
    }
};

struct EpiPlainCnt {
    static constexpr bool PERM = true, AFTER_DRAIN = false;
    bf16_t* O; int ldc; unsigned* cntA; unsigned* cntB;
    __device__ __forceinline__ void operator()(const f32x4 (&acc)[2][2][4][2], const Unit& u, int wr, int wc, int fr, int fq) const {
        const int row0 = u.pm * BM + wr * 64 + fr, col0 = u.pn * BM + wc * 32 + 8 * fq;
        const __amdgpu_buffer_rsrc_t rsrc = __builtin_amdgcn_make_buffer_rsrc(O, 0, 33280 * 1024 * 2, 0x00020000);
#pragma unroll
        for (int ai = 0; ai < 2; ++ai)
#pragma unroll
            for (int m = 0; m < 4; ++m) {
                const unsigned boff = (unsigned)(((row0 + ai * HALF + m * 16) * ldc + col0) * 2);
#pragma unroll
                for (int bj = 0; bj < 2; ++bj) { const f32x4 v0 = acc[ai][bj][m][0], v1 = acc[ai][bj][m][1]; u32x4 w;
                    w.x = cvt_pk_bf16(v0[0], v0[1]); w.y = cvt_pk_bf16(v0[2], v0[3]); w.z = cvt_pk_bf16(v1[0], v1[1]); w.w = cvt_pk_bf16(v1[2], v1[3]);
                    __builtin_amdgcn_raw_buffer_store_b128(w, rsrc, boff + bj * HALF * 2, 0,   16); }
            }
        asm volatile("s_waitcnt vmcnt(0)" ::: "memory");
        __builtin_amdgcn_s_barrier();
        if (threadIdx.x == 0) __hip_atomic_fetch_add(cntA + 64 * u.pm, 1u, __ATOMIC_RELAXED, __HIP_MEMORY_SCOPE_AGENT);
    }
};
struct PanelOrder {
    int nwg, G, vc;
    __device__ void init(int M, int G_, int vc_) { nwg = (M / BM) * 4; G = G_; vc = vc_; }
    __device__ bool next(int i, Unit& u) const { const int L = i * G + vc; if (L >= nwg) return false; u.pm = L >> 2; u.pn = L & 3; u.k0 = 0; return true; }
    __device__ __forceinline__ void a_ready(const Unit&) const {}
    __device__ __forceinline__ void done(const Unit&) const {}
};
struct OneUnitOrder {
    int pm, pn;
    __device__ bool next(int i, Unit& u) const { if (i > 0) return false; u.pm = pm; u.pn = pn; u.k0 = 0; return true; }
    __device__ __forceinline__ void a_ready(const Unit&) const {}
    __device__ __forceinline__ void done(const Unit&) const {}
};
struct SampleSplitOrder {
    int vc, khalf;
    __device__ bool next(int i, Unit& u) const { if (i > 0 || vc >= 16) return false; u.pm = 128 + (vc >> 3); u.pn = (vc >> 1) & 3; u.k0 = (vc & 1) * khalf; return true; }
    __device__ __forceinline__ void a_ready(const Unit&) const {}
    __device__ __forceinline__ void done(const Unit&) const {}
};
struct SampleSplit4Order {
    int li, k0;
    __device__ bool next(int i, Unit& u) const { if (i > 0) return false; u.pm = 128 + (li >> 4); u.pn = (li >> 2) & 3; u.k0 = k0; return true; }
    __device__ __forceinline__ void a_ready(const Unit&) const {}
    __device__ __forceinline__ void done(const Unit&) const {}
};
struct EpiPart4F32 {
    static constexpr bool PERM = true, AFTER_DRAIN = false;
    float* CS; int part; unsigned* cnt;
    __device__ __forceinline__ void operator()(const f32x4 (&acc)[2][2][4][2], const Unit& u, int wr, int wc, int fr, int fq) const {
        const int row0 = (u.pm - 128) * BM + wr * 64 + fr, col0 = u.pn * BM + wc * 32 + 8 * fq;
        const __amdgpu_buffer_rsrc_t rsrc = __builtin_amdgcn_make_buffer_rsrc(CS, 0, 4 * 512 * 1024 * 4, 0x00020000);
        const unsigned hoff = (unsigned)part * 512u * 1024u * 4u;
#pragma unroll
        for (int ai = 0; ai < 2; ++ai)
#pragma unroll
            for (int m = 0; m < 4; ++m) {
                const unsigned boff = hoff + (unsigned)(((row0 + ai * HALF + m * 16) * 1024 + col0) * 4);
#pragma unroll
                for (int bj = 0; bj < 2; ++bj) { __builtin_amdgcn_raw_buffer_store_b128(__builtin_bit_cast(u32x4, acc[ai][bj][m][0]), rsrc, boff + bj * HALF * 4, 0, 16);
                    __builtin_amdgcn_raw_buffer_store_b128(__builtin_bit_cast(u32x4, acc[ai][bj][m][1]), rsrc, boff + bj * HALF * 4 + 16, 0, 16); }
            }
        asm volatile("s_waitcnt vmcnt(0)" ::: "memory");
        __builtin_amdgcn_s_barrier();
        if (threadIdx.x == 0) __hip_atomic_fetch_add(cnt, 1u, __ATOMIC_RELAXED, __HIP_MEMORY_SCOPE_AGENT);
    }
};
struct EpiPartF32 {
    static constexpr bool PERM = true, AFTER_DRAIN = false;
    float* CS; int khalf; unsigned* cnt;
    __device__ __forceinline__ void operator()(const f32x4 (&acc)[2][2][4][2], const Unit& u, int wr, int wc, int fr, int fq) const {
        const int row0 = (u.pm - 128) * BM + wr * 64 + fr, col0 = u.pn * BM + wc * 32 + 8 * fq;
        const __amdgpu_buffer_rsrc_t rsrc = __builtin_amdgcn_make_buffer_rsrc(CS, 0, 2 * 512 * 1024 * 4, 0x00020000);
        const unsigned hoff = (u.k0 ? 1u : 0u) * 512u * 1024u * 4u;
#pragma unroll
        for (int ai = 0; ai < 2; ++ai)
#pragma unroll
            for (int m = 0; m < 4; ++m) {
                const unsigned boff = hoff + (unsigned)(((row0 + ai * HALF + m * 16) * 1024 + col0) * 4);
#pragma unroll
                for (int bj = 0; bj < 2; ++bj) { __builtin_amdgcn_raw_buffer_store_b128(__builtin_bit_cast(u32x4, acc[ai][bj][m][0]), rsrc, boff + bj * HALF * 4, 0, 16);
                    __builtin_amdgcn_raw_buffer_store_b128(__builtin_bit_cast(u32x4, acc[ai][bj][m][1]), rsrc, boff + bj * HALF * 4 + 16, 0, 16); }
            }
        asm volatile("s_waitcnt vmcnt(0)" ::: "memory");
        __builtin_amdgcn_s_barrier();
        if (threadIdx.x == 0) __hip_atomic_fetch_add(cnt, 1u, __ATOMIC_RELAXED, __HIP_MEMORY_SCOPE_AGENT);
    }
};
}

#include <hip/hip_cooperative_groups.h>
namespace cg = cooperative_groups;

#define LAS __attribute__((address_space(3)))
typedef unsigned short bf16;
typedef unsigned v4u __attribute__((ext_vector_type(4)));
typedef unsigned v2u __attribute__((ext_vector_type(2)));
typedef float f32x4 __attribute__((ext_vector_type(4)));
typedef float f32x16 __attribute__((ext_vector_type(16)));
typedef short bf16x8 __attribute__((ext_vector_type(8)));
typedef short s16x4 __attribute__((ext_vector_type(4)));

constexpr int NWAVES = 8, NTHR = 512;
constexpr int D = 1024, FF = 2816, NPROW = 32768, NSROW = 512, M = NPROW + NSROW, SEQ = 8192, NB = 4, DB = 128, INW = 1280;
constexpr float EPS = 1e-6f;
constexpr size_t MiB = 1u << 20;
constexpr size_t WS_ROPE = 1 * MiB, WS_SSM = 2 * MiB, WS_MN = 3 * MiB;
constexpr size_t WS_W1GU = 5 * MiB, WS_W1D = 16 * MiB, WS_W2GU = 22 * MiB, WS_W2D = 33 * MiB, WS_WIN = 39 * MiB, WS_WGLU = 42 * MiB, WS_WOUT = 43 * MiB, WS_WMQ = 45 * MiB, WS_WMKV = 47 * MiB, WS_WMO = 51 * MiB;
constexpr size_t WS_XN = 56 * MiB, WS_CB = 121 * MiB, WS_ACT = 186 * MiB;
constexpr size_t WS_Z = 186 * MiB, WS_G = 268 * MiB, WS_E = 301 * MiB, WS_Q2 = 186 * MiB, WS_O2 = 252 * MiB;
constexpr size_t WS_MK = 365 * MiB, WS_MVT = 367 * MiB, WS_END = 369 * MiB;
constexpr size_t CTL_CNT = 65536, CTL_ZERO = 327680, WS_RS = 53 * MiB, WS_HB = 369 * MiB, WS_CS = 434 * MiB, WS_CS4 = 438 * MiB, WS_END2 = 446 * MiB;
constexpr size_t SSM_LAMT = 0, SSM_BBF = 128 * 1024, SSM_CMF = 256 * 1024;
constexpr size_t O_PSRE = (size_t)M * D, O_PSIM = O_PSRE + 8192, O_PWK = O_PSIM + 8192, O_PWV = O_PWK + 65536, O_PMK = O_PWV + 65536, O_PMV = O_PMK + 1048576,
                 O_SSRE = O_PMV + 1048576, O_SSIM = O_SSRE + 262144, O_SWK = O_SSIM + 262144, O_SWV = O_SWK + 2097152, O_END = O_SWV + 2097152;
constexpr int LDS_BYTES = 147456;

struct Args { const float* in[43]; float* out; unsigned char* ws; int ph_lo, ph_hi; };

__device__ __forceinline__ unsigned f2bf(float f) { unsigned u = __builtin_bit_cast(unsigned, f); return (u + 0x7fffu + ((u >> 16) & 1u)) >> 16; }
__device__ __forceinline__ unsigned pk2(float lo, float hi) { return pg8::cvt_pk_bf16(lo, hi); }
__device__ __forceinline__ float bf2f(bf16 b) { return __uint_as_float((unsigned)b << 16); }
__device__ __forceinline__ float wave_sum(float v) {
    v += xl_dpp_b1(v); v += xl_dpp_4e(v); v += xl_mir8(v); v += xl_mir16(v); v += xl_xor16(v); v += xl_xor32(v);
    return v;
}
__device__ __forceinline__ float wave_max(float v) {
    v = fmaxf(v, xl_dpp_b1(v)); v = fmaxf(v, xl_dpp_4e(v)); v = fmaxf(v, xl_mir8(v)); v = fmaxf(v, xl_mir16(v)); v = fmaxf(v, xl_xor16(v)); v = fmaxf(v, xl_xor32(v));
    return v;
}
__device__ __forceinline__ void dsincos(double x, double& s, double& c) {
    const double k = rint(x * 0.63661977236758134308);
    double r = fma(-k, 1.57079632679489655800e+00, x); r = fma(-k, 6.12323399573676603587e-17, r);
    const long long q = (long long)k; const double r2 = r * r;
    double sp = -1.0 / 1307674368000.0; sp = fma(sp, r2, 1.0 / 6227020800.0); sp = fma(sp, r2, -1.0 / 39916800.0); sp = fma(sp, r2, 1.0 / 362880.0); sp = fma(sp, r2, -1.0 / 5040.0);
    sp = fma(sp, r2, 1.0 / 120.0); sp = fma(sp, r2, -1.0 / 6.0); sp = fma(sp * r2, r, r);
    double cp = 1.0 / 20922789888000.0; cp = fma(cp, r2, -1.0 / 87178291200.0); cp = fma(cp, r2, 1.0 / 479001600.0); cp = fma(cp, r2, -1.0 / 3628800.0); cp = fma(cp, r2, 1.0 / 40320.0);
    cp = fma(cp, r2, -1.0 / 720.0); cp = fma(cp, r2, 1.0 / 24.0); cp = fma(cp, r2, -0.5); cp = fma(cp, r2, 1.0);
    const int qq = (int)(q & 3);
    s = (qq == 0) ? sp : (qq == 1) ? cp : (qq == 2) ? -sp : -cp;
    c = (qq == 0) ? cp : (qq == 1) ? -sp : (qq == 2) ? -cp : sp;
}
__device__ __forceinline__ double dexp(double x) {
    const double k = rint(x * 1.4426950408889634074);
    double r = fma(-k, 6.93147180369123816490e-01, x); r = fma(-k, 1.90821492927058770002e-10, r);
    double p = 1.0;
#pragma unroll
    for (int i = 14; i >= 1; --i) p = fma(p, r * (1.0 / (double)i), 1.0);
    const long long e = (long long)k + 1023;
    return p * __longlong_as_double((long long)((unsigned long long)e << 52));
}

struct Frame {
    LAS unsigned char* lds;
    int tid, lane, wave, G;
    const float* const* in; float* out; unsigned char* ws;
};
#define INP(k) (F.in[k])
__device__ __forceinline__ const float* xrow_ptr(const Frame& F, int row) { return row < NPROW ? INP(0) + (size_t)row * D : INP(1) + (size_t)(row - NPROW) * D; }

__device__ __forceinline__ void p0_transpose_item(const float* W, int K, int N, bf16* WT, int row_off, int mode, LAS float* scr, int item, int lane, const float* gk = nullptr) {
    const int nblk = N / 32, kb = item / nblk, nb = item % nblk, k0 = 64 * kb, n0 = 32 * nb;
    const int drow0 = mode == 0 ? row_off + n0 : (256 * (n0 >> 7) + (n0 & 127) + (mode == 2 ? 128 : 0));
    float wv[32];
#pragma unroll
    for (int i = 0; i < 32; ++i) { const int kk = 2 * i + (lane >> 5); wv[i] = W[(size_t)(k0 + kk) * N + n0 + (lane & 31)]; }
#pragma unroll
    for (int i = 0; i < 32; ++i) { const int kk = 2 * i + (lane >> 5); scr[kk * 33 + (lane & 31)] = wv[i]; }
    asm volatile("s_waitcnt lgkmcnt(0)" ::: "memory");
    const int c = lane & 7;
    f32x4 ga = {1.f, 1.f, 1.f, 1.f}, gb = {1.f, 1.f, 1.f, 1.f};
    if (gk) { ga = *(const f32x4*)(gk + k0 + 8 * c); gb = *(const f32x4*)(gk + k0 + 8 * c + 4); }
#pragma unroll
    for (int j = 0; j < 4; ++j) { const int n = (lane >> 3) + 8 * j; const LAS float* s = scr + (8 * c) * 33 + n;
        v4u o; o.x = pk2(s[0 * 33] * ga.x, s[1 * 33] * ga.y); o.y = pk2(s[2 * 33] * ga.z, s[3 * 33] * ga.w); o.z = pk2(s[4 * 33] * gb.x, s[5 * 33] * gb.y); o.w = pk2(s[6 * 33] * gb.z, s[7 * 33] * gb.w);
        *(v4u*)(WT + (size_t)(drow0 + n) * K + k0 + 8 * c) = o; }
    asm volatile("s_waitcnt lgkmcnt(0)" ::: "memory");
}
__device__ __forceinline__ void rms_row_to_bf16(const Frame& F, const float* xrow, const float* g, bf16* orow) {
    const f32x4* xr = (const f32x4*)xrow + F.lane; const f32x4* gr = (const f32x4*)g + F.lane;
    f32x4 v[4]; float s = 0.f;
#pragma unroll
    for (int j = 0; j < 4; ++j) { v[j] = xr[64 * j]; s += (v[j].x * v[j].x + v[j].y * v[j].y) + (v[j].z * v[j].z + v[j].w * v[j].w); }
    const float r = 1.0f / sqrtf(wave_sum(s) * (1.f / D) + EPS);
    v2u* o8 = (v2u*)orow + F.lane;
#pragma unroll
    for (int j = 0; j < 4; ++j) { const f32x4 gg = gr[64 * j]; v2u w; w.x = pk2(v[j].x * r * gg.x, v[j].y * r * gg.y); w.y = pk2(v[j].z * r * gg.z, v[j].w * r * gg.w); o8[64 * j] = w; }
}
__device__ __forceinline__ void p0_prologue(const Frame& F) {
    LAS float* scr = (LAS float*)(F.lds + F.wave * 16384);
    const int gw = blockIdx.x * NWAVES + F.wave, NGW = F.G * NWAVES;
    bf16* const ws16 = (bf16*)F.ws;
    constexpr int I_GU = (D / 64) * (FF / 32), I_DN = (FF / 64) * (D / 32), I_IN = (D / 64) * (INW / 32), I_GL = (512 / 64) * (512 / 32), I_SQ = (D / 64) * (D / 32);
    constexpr int NITEMS = 2 * I_GU + I_DN + I_IN + I_GL + 5 * I_SQ;
    for (int it = gw; it < NITEMS; it += NGW) {
        int r = it;
        if (r < I_GU) { p0_transpose_item(INP(10), D, FF, (bf16*)(F.ws + WS_W1GU), 0, 1, scr, r, F.lane, INP(9)); continue; } r -= I_GU;
        if (r < I_GU) { p0_transpose_item(INP(11), D, FF, (bf16*)(F.ws + WS_W1GU), 0, 2, scr, r, F.lane, INP(9)); continue; } r -= I_GU;
        if (r < I_DN) { p0_transpose_item(INP(12), FF, D, (bf16*)(F.ws + WS_W1D), 0, 0, scr, r, F.lane); continue; } r -= I_DN;
        if (r < I_IN) { p0_transpose_item(INP(15), D, INW, (bf16*)(F.ws + WS_WIN), 0, 0, scr, r, F.lane, INP(14)); continue; } r -= I_IN;
        if (r < I_GL) { p0_transpose_item(INP(24), 512, 512, (bf16*)(F.ws + WS_WGLU), 0, 0, scr, r, F.lane); continue; } r -= I_GL;
        if (r < I_SQ) { p0_transpose_item(INP(29), D, D, (bf16*)(F.ws + WS_WOUT), 0, 0, scr, r, F.lane); continue; } r -= I_SQ;
        if (r < I_SQ) { p0_transpose_item(INP(32), D, D, (bf16*)(F.ws + WS_WMQ), 0, 0, scr, r, F.lane, INP(36)); continue; } r -= I_SQ;
        if (r < I_SQ) { p0_transpose_item(INP(33), D, D, (bf16*)(F.ws + WS_WMKV), 0, 0, scr, r, F.lane); continue; } r -= I_SQ;
        if (r < I_SQ) { p0_transpose_item(INP(34), D, D, (bf16*)(F.ws + WS_WMKV), 1024, 0, scr, r, F.lane); continue; } r -= I_SQ;
        p0_transpose_item(INP(35), D, D, (bf16*)(F.ws + WS_WMO), 0, 0, scr, r, F.lane);
    }
    (void)ws16;
    for (int m0 = gw; m0 < M + 1024; m0 += 4 * NGW) {
        f32x4 v[4][4];
#pragma unroll
        for (int k = 0; k < 4; ++k) { const int m = m0 + k * NGW; if (m < M + 1024) { const f32x4* xr = (const f32x4*)(m < M ? xrow_ptr(F, m) : INP(8) + (size_t)(m - M) * D) + F.lane;
#pragma unroll
            for (int j = 0; j < 4; ++j) v[k][j] = xr[64 * j]; } }
#pragma unroll
        for (int k = 0; k < 4; ++k) { const int m = m0 + k * NGW; if (m < M + 1024) {
            float sq = 0.f;
#pragma unroll
            for (int j = 0; j < 4; ++j) sq += (v[k][j].x * v[k][j].x + v[k][j].y * v[k][j].y) + (v[k][j].z * v[k][j].z + v[k][j].w * v[k][j].w);
            const float r = 1.0f / sqrtf(wave_sum(sq) * (1.f / D) + EPS);
            if (m < M) {
                if (F.lane == 0) ((float*)(F.ws + WS_RS))[m] = r;
                v2u* o8 = (v2u*)((bf16*)(F.ws + WS_HB) + (size_t)m * D) + F.lane;
#pragma unroll
                for (int j = 0; j < 4; ++j) { v2u w; w.x = pk2(v[k][j].x, v[k][j].y); w.y = pk2(v[k][j].z, v[k][j].w); o8[64 * j] = w; }
            } else {
                const f32x4* gr = (const f32x4*)INP(31) + F.lane;
                v2u* o8 = (v2u*)((bf16*)(F.ws + WS_MN) + (size_t)(m - M) * D) + F.lane;
#pragma unroll
                for (int j = 0; j < 4; ++j) { const f32x4 gg = gr[64 * j]; v2u w; w.x = pk2(v[k][j].x * r * gg.x, v[k][j].y * r * gg.y); w.y = pk2(v[k][j].z * r * gg.z, v[k][j].w * r * gg.w); o8[64 * j] = w; }
            } } }
    }
    const int gt = blockIdx.x * NTHR + F.tid, NGT = F.G * NTHR;
    for (int i = gt; i < 8196 * 8; i += NGT) {
        const int pi = i >> 3, fi = i & 7; const double pos = pi < 8192 ? (double)pi : (double)(16384 + (pi - 8192));
        const double inv = dexp(-(double)fi * 0.125 * 13.122363377404328);
        double s, c; dsincos(pos * inv, s, c);
        ((float2*)(F.ws + WS_ROPE))[i] = make_float2((float)c, (float)s);
    }
    for (int i = gt; i < 32 * 64; i += NGT) {
        const int g = i >> 6, p = i & 63;
        const double are = (double)INP(16)[i], aim = (double)INP(17)[i], dt = dexp((double)INP(18)[g]);
        float* lamt = (float*)(F.ws + WS_SSM + SSM_LAMT);
        double lbr = 0, lbi = 0;
#pragma unroll
        for (int k = 0; k < 5; ++k) { const double pw = k < 4 ? (double)(k + 1) : 128.0; const double mag = dexp(are * dt * pw); double s, c; dsincos(aim * dt * pw, s, c);
            lamt[((g * 5 + k) * 64 + p) * 2 + 0] = (float)(mag * c); lamt[((g * 5 + k) * 64 + p) * 2 + 1] = (float)(mag * s); if (k == 0) { lbr = mag * c; lbi = mag * s; } }
        const double den = are * are + aim * aim, nre = lbr - 1.0, nim = lbi;
        const double cre = (nre * are + nim * aim) / den, cim = (nim * are - nre * aim) / den;
        bf16* bbf = (bf16*)(F.ws + WS_SSM + SSM_BBF); bf16* cmf = (bf16*)(F.ws + WS_SSM + SSM_CMF);
        for (int ch = 0; ch < 16; ++ch) {
            const double bre = (double)INP(19)[(size_t)i * 16 + ch], bim = (double)INP(20)[(size_t)i * 16 + ch];
            bbf[(g * 128 + p) * 16 + ch] = (bf16)f2bf((float)(cre * bre - cim * bim));
            bbf[(g * 128 + 64 + p) * 16 + ch] = (bf16)f2bf((float)(cre * bim + cim * bre));
            cmf[(g * 16 + ch) * 128 + 4 * (p & 31) + (p >> 5)] = (bf16)f2bf(INP(21)[(g * 16 + ch) * 64 + p]);
            cmf[(g * 16 + ch) * 128 + 4 * (p & 31) + 2 + (p >> 5)] = (bf16)f2bf(-INP(22)[(g * 16 + ch) * 64 + p]);
        }
    }
}

template <bool PART> __device__ __forceinline__ void ew_rows(const Frame& F, const bf16* C, const float* gpost, float wgt, bool final, float* rs_out, int rbeg, int rend, int widx, int nw) {
    constexpr int R = 4;
    bf16* HB = (bf16*)(F.ws + WS_HB);
    f32x4 gpo[4];
#pragma unroll
    for (int j = 0; j < 4; ++j) gpo[j] = ((const f32x4*)gpost + F.lane)[64 * j];
    for (int row0 = rbeg + widx; row0 < rend; row0 += R * nw) {
        v2u hw[R][4], cw[R][4]; f32x4 cf[PART ? R : 1][4];
#pragma unroll
        for (int k = 0; k < R; ++k) { const int row = row0 + k * nw; if (row < rend) {
            const v2u* hr = (const v2u*)(HB + (size_t)row * D) + F.lane;
            if (PART) {
                const f32x4* c0 = (const f32x4*)((const float*)(F.ws + WS_CS4) + (size_t)(row - NPROW) * D) + F.lane; constexpr int PS = 512 * 1024 / 4;
#pragma unroll
                for (int j = 0; j < 4; ++j) { cf[PART ? k : 0][j] = (c0[64 * j] + c0[PS + 64 * j]) + (c0[2 * PS + 64 * j] + c0[3 * PS + 64 * j]); hw[k][j] = hr[64 * j]; }
            } else {
                const v2u* cr = (const v2u*)(C + (size_t)row * D) + F.lane;
#pragma unroll
                for (int j = 0; j < 4; ++j) { cw[k][j] = cr[64 * j]; hw[k][j] = hr[64 * j]; }
            } } }
#pragma unroll
        for (int k = 0; k < R; ++k) { const int row = row0 + k * nw; if (row < rend) {
            f32x4 c[4], h[4]; float s = 0.f;
#pragma unroll
            for (int j = 0; j < 4; ++j) { if (PART) c[j] = cf[PART ? k : 0][j]; else { const v2u w = cw[k][j]; c[j] = (f32x4){pg8::bflo(w.x), pg8::bfhi(w.x), pg8::bflo(w.y), pg8::bfhi(w.y)}; }
                s += (c[j].x * c[j].x + c[j].y * c[j].y) + (c[j].z * c[j].z + c[j].w * c[j].w); }
            const float r = wgt / sqrtf(wave_sum(s) * (1.f / D) + EPS);
            float s2 = 0.f;
#pragma unroll
            for (int j = 0; j < 4; ++j) { const v2u w = hw[k][j]; h[j] = (f32x4){pg8::bflo(w.x), pg8::bfhi(w.x), pg8::bflo(w.y), pg8::bfhi(w.y)} + c[j] * r * gpo[j];
                s2 += (h[j].x * h[j].x + h[j].y * h[j].y) + (h[j].z * h[j].z + h[j].w * h[j].w); }
            if (final) {
                f32x4* ho = (f32x4*)(F.out + (size_t)row * D) + F.lane;
#pragma unroll
                for (int j = 0; j < 4; ++j) ho[64 * j] = h[j];
            } else {
                const float r2 = 1.0f / sqrtf(wave_sum(s2) * (1.f / D) + EPS);
                if (F.lane == 0) rs_out[row] = r2;
                v2u* o8 = (v2u*)(HB + (size_t)row * D) + F.lane;
#pragma unroll
                for (int j = 0; j < 4; ++j) { v2u w; w.x = pk2(h[j].x, h[j].y); w.y = pk2(h[j].z, h[j].w); o8[64 * j] = w; }
            } } }
    }
}
__device__ __forceinline__ void mix_rows(const Frame& F, int rbeg, int rend, int widx, int nw) {
    const bf16* YO = (const bf16*)(F.ws + WS_CB); bf16* XN = (bf16*)(F.ws + WS_XN);
    f32x4 ga[2][2];
#pragma unroll
    for (int hf = 0; hf < 2; ++hf) { const float* g = (hf == 0 ? INP(27) : INP(28)) + 8 * F.lane; ga[hf][0] = *(const f32x4*)g; ga[hf][1] = *(const f32x4*)(g + 4); }
    for (int row0 = rbeg + widx; row0 < rend; row0 += 4 * nw) {
        v4u wv[4][2];
#pragma unroll
        for (int k = 0; k < 4; ++k) { const int row = row0 + k * nw; if (row < rend) {
#pragma unroll
            for (int hf = 0; hf < 2; ++hf) wv[k][hf] = *((const v4u*)(YO + (size_t)row * D + hf * 512) + F.lane); } }
#pragma unroll
        for (int k = 0; k < 4; ++k) { const int row = row0 + k * nw; if (row < rend) {
#pragma unroll
            for (int hf = 0; hf < 2; ++hf) {
                const v4u w = wv[k][hf];
                float v[8] = {pg8::bflo(w.x), pg8::bfhi(w.x), pg8::bflo(w.y), pg8::bfhi(w.y), pg8::bflo(w.z), pg8::bfhi(w.z), pg8::bflo(w.w), pg8::bfhi(w.w)};
                float sq = 0.f;
#pragma unroll
                for (int e = 0; e < 8; ++e) sq += v[e] * v[e];
                const float r = 1.0f / sqrtf(wave_sum(sq) * (1.f / 512.f) + EPS);
                const f32x4 g0 = ga[hf][0], g1 = ga[hf][1];
                v4u o; o.x = pk2(v[0] * r * g0.x, v[1] * r * g0.y); o.y = pk2(v[2] * r * g0.z, v[3] * r * g0.w); o.z = pk2(v[4] * r * g1.x, v[5] * r * g1.y); o.w = pk2(v[6] * r * g1.z, v[7] * r * g1.w);
                *((v4u*)(XN + (size_t)row * D + hf * 512) + F.lane) = o;
            } } }
    }
}

__device__ __forceinline__ float gelu_tanh(float y) {
    const float t = 0.7978845608028654f * (y + 0.044715f * y * y * y);
    const float th = 1.0f - 2.0f * __builtin_amdgcn_rcpf(1.0f + __expf(2.0f * t));
    return 0.5f * y * (1.0f + th);
}
template <bool PASS2>
__device__ __forceinline__ void ssm_unit(const Frame& F, int g, int row0, int ntok, float (&S)[4], LAS unsigned char* slds) {
    const int lane = F.lane, c = lane & 31, h = lane >> 5;
    const bf16* Z = (const bf16*)(F.ws + WS_Z);
    const bf16* bbf = (const bf16*)(F.ws + WS_SSM + SSM_BBF) + (size_t)g * 128 * 16;
    const float* lamt = (const float*)(F.ws + WS_SSM + SSM_LAMT) + (size_t)g * 5 * 64 * 2;
    bf16x8 Bf[4];
#pragma unroll
    for (int n = 0; n < 4; ++n) Bf[n] = *(const bf16x8*)(bbf + (32 * n + c) * 16 + 8 * h);
    float lr[2][4], li[2][4];
#pragma unroll
    for (int st = 0; st < 2; ++st)
#pragma unroll
        for (int k = 0; k < 4; ++k) { const float2 l = *(const float2*)(lamt + (k * 64 + 32 * st + c) * 2); lr[st][k] = l.x; li[st][k] = l.y; }
    bf16x8 Cf[4]; float dv = 0.f;
    if (PASS2) {
        const bf16* cmf = (const bf16*)(F.ws + WS_SSM + SSM_CMF) + (size_t)g * 16 * 128;
#pragma unroll
        for (int ks = 0; ks < 4; ++ks) Cf[ks] = *(const bf16x8*)(cmf + (lane & 15) * 128 + 32 * ks + 8 * (lane >> 4));
        dv = INP(23)[g * 16 + (lane & 15)];
    }
    const int nsub = (ntok + 31) >> 5, qe = ((ntok - 1) & 31) >> 2;
    float fin[4] = {0.f, 0.f, 0.f, 0.f};
    bf16x8 Unext = (bf16x8){0, 0, 0, 0, 0, 0, 0, 0};
    if (c < ntok) Unext = *(const bf16x8*)(Z + (size_t)(row0 + c) * INW + g * 16 + 8 * h);
    for (int sub = 0; sub < nsub; ++sub) {
        const int t0 = 32 * sub;
        const bf16x8 Uf = Unext;
        Unext = (bf16x8){0, 0, 0, 0, 0, 0, 0, 0};
        if (t0 + 32 + c < ntok) Unext = *(const bf16x8*)(Z + (size_t)(row0 + t0 + 32 + c) * INW + g * 16 + 8 * h);
        f32x16 a[4];
#pragma unroll
        for (int n = 0; n < 4; ++n) { f32x16 z = {}; a[n] = __builtin_amdgcn_mfma_f32_32x32x16_bf16(Uf, Bf[n], z, 0, 0, 0); }
#pragma unroll
        for (int i = 0; i < 4; ++i)
#pragma unroll
            for (int k = 1; k < 4; ++k)
#pragma unroll
                for (int st = 0; st < 2; ++st) {
                    const float pr = a[st][4 * i + k - 1], pi = a[2 + st][4 * i + k - 1];
                    a[st][4 * i + k] = fmaf(lr[st][0], pr, fmaf(-li[st][0], pi, a[st][4 * i + k]));
                    a[2 + st][4 * i + k] = fmaf(lr[st][0], pi, fmaf(li[st][0], pr, a[2 + st][4 * i + k]));
                }
        float Sin[4][4];
#pragma unroll
        for (int q = 0; q < 8; ++q) {
            const int i = q >> 1;
            if ((q & 1) == 0) {
#pragma unroll
                for (int e = 0; e < 4; ++e) Sin[i][e] = S[e];
            } else {
#pragma unroll
                for (int e = 0; e < 4; ++e) Sin[i][e] = h ? S[e] : Sin[i][e];
            }
            float o[4];
            o[0] = fmaf(lr[0][3], S[0], fmaf(-li[0][3], S[1], a[0][4 * i + 3])); o[1] = fmaf(lr[0][3], S[1], fmaf(li[0][3], S[0], a[2][4 * i + 3]));
            o[2] = fmaf(lr[1][3], S[2], fmaf(-li[1][3], S[3], a[1][4 * i + 3])); o[3] = fmaf(lr[1][3], S[3], fmaf(li[1][3], S[2], a[3][4 * i + 3]));
#pragma unroll
            for (int e = 0; e < 4; ++e) S[e] = xl_xor32(o[e]);
            if (sub == nsub - 1 && q == qe) {
#pragma unroll
                for (int e = 0; e < 4; ++e) fin[e] = S[e];
            }
        }
        float uvals[8];
        if (PASS2) {
#pragma unroll
            for (int mb = 0; mb < 2; ++mb)
#pragma unroll
                for (int r = 0; r < 4; ++r) { int tok = t0 + 16 * mb + 4 * (lane >> 4) + r; tok = tok < ntok ? tok : ntok - 1;
                    uvals[mb * 4 + r] = bf2f(Z[(size_t)(row0 + tok) * INW + g * 16 + (lane & 15)]); }
        }
        if (PASS2) {
#pragma unroll
            for (int i = 0; i < 4; ++i)
#pragma unroll
                for (int k = 0; k < 4; ++k)
#pragma unroll
                    for (int st = 0; st < 2; ++st) {
                        const float sr = Sin[i][2 * st], si = Sin[i][2 * st + 1];
                        a[st][4 * i + k] = fmaf(lr[st][k], sr, fmaf(-li[st][k], si, a[st][4 * i + k]));
                        a[2 + st][4 * i + k] = fmaf(lr[st][k], si, fmaf(li[st][k], sr, a[2 + st][4 * i + k]));
                    }
#pragma unroll
            for (int i = 0; i < 4; ++i)
#pragma unroll
                for (int k = 0; k < 4; ++k) {
                    const int tok = 8 * i + 4 * h + k; v2u w; w.x = pk2(a[0][4 * i + k], a[1][4 * i + k]); w.y = pk2(a[2][4 * i + k], a[3][4 * i + k]);
                    *(LAS v2u*)(slds + tok * 272 + c * 8) = w;
                }
            asm volatile("s_waitcnt lgkmcnt(0)" ::: "memory");
            f32x4 Y[2];
#pragma unroll
            for (int mb = 0; mb < 2; ++mb) { Y[mb] = (f32x4){0.f, 0.f, 0.f, 0.f};
#pragma unroll
                for (int ks = 0; ks < 4; ++ks) { const bf16x8 Af = *(const LAS bf16x8*)(slds + (16 * mb + (lane & 15)) * 272 + (32 * ks + 8 * (lane >> 4)) * 2);
                    Y[mb] = __builtin_amdgcn_mfma_f32_16x16x32_bf16(Af, Cf[ks], Y[mb], 0, 0, 0); } }
            asm volatile("s_waitcnt lgkmcnt(0)" ::: "memory");
            bf16* Gb = (bf16*)(F.ws + WS_G);
#pragma unroll
            for (int mb = 0; mb < 2; ++mb)
#pragma unroll
                for (int r = 0; r < 4; ++r) {
                    const int tok = t0 + 16 * mb + 4 * (lane >> 4) + r;
                    if (tok < ntok) { const size_t row = (size_t)(row0 + tok); const float uval = uvals[mb * 4 + r];
                        Gb[row * 512 + g * 16 + (lane & 15)] = (bf16)f2bf(gelu_tanh(Y[mb][r] + dv * uval)); }
                }
        }
    }
#pragma unroll
    for (int e = 0; e < 4; ++e) S[e] = fin[e];
}
__device__ __forceinline__ void ssm_pass1(const Frame& F) {
    const int gw = blockIdx.x * NWAVES + F.wave, NGW = F.G * NWAVES;
    float* E = (float*)(F.ws + WS_E);
    for (int u = gw; u < NB * 63 * 32; u += NGW) {
        const int g = u & 31, cch = (u >> 5) % 63, b = (u >> 5) / 63;
        float S[4] = {0.f, 0.f, 0.f, 0.f};
        ssm_unit<false>(F, g, b * SEQ + cch * 128, 128, S, F.lds);
        if (F.lane < 32) { float* e = E + ((size_t)(b * 32 + g) * 64 + cch) * 128 + F.lane; e[0] = S[0]; e[64] = S[1]; e[32] = S[2]; e[96] = S[3]; }
    }
}
__device__ __forceinline__ void ssm_pass2(const Frame& F) {
    const int gw = blockIdx.x * NWAVES + F.wave, NGW = F.G * NWAVES;
    const float* E = (const float*)(F.ws + WS_E);
    LAS unsigned char* slds = F.lds + F.wave * 8704;
    const int c = F.lane & 31;
    for (int u = gw; u < NB * 16 * 32 + DB * 32; u += NGW) {
        if (u < NB * 16 * 32) {
            const int g = u & 31, cq = (u >> 5) & 15, b = u >> 9;
            const float* lamt = (const float*)(F.ws + WS_SSM + SSM_LAMT) + (size_t)g * 5 * 64 * 2;
            const float2 L0 = *(const float2*)(lamt + (4 * 64 + c) * 2), L1 = *(const float2*)(lamt + (4 * 64 + 32 + c) * 2);
            float S[4] = {0.f, 0.f, 0.f, 0.f};
            const float* e = E + ((size_t)(b * 32 + g) * 64) * 128 + c;
#pragma unroll 4
            for (int j = 0; j < 4 * cq; ++j) {
                const float e0 = e[j * 128], e1 = e[j * 128 + 64], e2 = e[j * 128 + 32], e3 = e[j * 128 + 96];
                const float n0 = L0.x * S[0] - L0.y * S[1] + e0, n1 = L0.x * S[1] + L0.y * S[0] + e1, n2 = L1.x * S[2] - L1.y * S[3] + e2, n3 = L1.x * S[3] + L1.y * S[2] + e3;
                S[0] = n0; S[1] = n1; S[2] = n2; S[3] = n3;
            }
            for (int cc = 0; cc < 4; ++cc) ssm_unit<true>(F, g, b * SEQ + (4 * cq + cc) * 128, 128, S, slds);
            if (cq == 15 && F.lane < 32) { float* ore = F.out + O_PSRE + (size_t)(b * 32 + g) * 64 + c; float* oim = F.out + O_PSIM + (size_t)(b * 32 + g) * 64 + c;
                ore[0] = S[0]; oim[0] = S[1]; ore[32] = S[2]; oim[32] = S[3]; }
        } else {
            const int v = u - NB * 16 * 32, g = v & 31, b = v >> 5;
            const float* sre = INP(2) + (size_t)(b * 32 + g) * 64 + c; const float* sim = INP(3) + (size_t)(b * 32 + g) * 64 + c;
            float S[4] = {sre[0], sim[0], sre[32], sim[32]};
            ssm_unit<true>(F, g, NPROW + 4 * b, 4, S, slds);
            if (F.lane >= 32) { float* ore = F.out + O_SSRE + (size_t)(b * 32 + g) * 64 + c; float* oim = F.out + O_SSIM + (size_t)(b * 32 + g) * 64 + c;
                ore[0] = S[0]; oim[0] = S[1]; ore[32] = S[2]; oim[32] = S[3]; }
        }
    }
}

__device__ __forceinline__ void swa_prompt_unit(const Frame& F, int unit) {
    const int kvh = unit & 1, qblk = (unit >> 1) & 63, b = unit >> 7;
    const int tid = F.tid, lane = F.lane, w = F.wave, l15 = lane & 15, quad = lane >> 4;
    const bf16* Z = (const bf16*)(F.ws + WS_Z); bf16* YO = (bf16*)(F.ws + WS_CB);
    LAS unsigned char* Kl = F.lds; LAS unsigned char* Vl = F.lds + 36864;
    const int rowb = b * SEQ + qblk * 128;
    { const int d = tid >> 3, wq = tid & 7; *(LAS unsigned*)(Vl + d * 544 + 512 + 4 * wq) = 0u; }
#pragma unroll
    for (int i = 0; i < 4; ++i) {
        const int idx = tid + 512 * i, key = idx >> 3, ch = idx & 7;
        const bool inb = (qblk > 0 || key >= 128);
        const bf16* zr = Z + (size_t)(inb ? rowb - 128 + key : rowb) * INW;
        v4u kv = *(const v4u*)(zr + 1024 + kvh * 64 + ch * 8), vv = *(const v4u*)(zr + 1152 + kvh * 64 + ch * 8);
        if (!inb) { kv = (v4u){0u, 0u, 0u, 0u}; vv = (v4u){0u, 0u, 0u, 0u}; }
        *(LAS v4u*)(Kl + key * 144 + ch * 16) = kv;
        LAS unsigned short* vp = (LAS unsigned short*)(Vl + (8 * ch) * 544) + key;
        vp[0 * 272] = (unsigned short)vv.x; vp[1 * 272] = (unsigned short)(vv.x >> 16); vp[2 * 272] = (unsigned short)vv.y; vp[3 * 272] = (unsigned short)(vv.y >> 16);
        vp[4 * 272] = (unsigned short)vv.z; vp[5 * 272] = (unsigned short)(vv.z >> 16); vp[6 * 272] = (unsigned short)vv.w; vp[7 * 272] = (unsigned short)(vv.w >> 16);
        if (qblk == 63 && key >= 128) {
            float* ok = F.out + O_PWK + ((size_t)(b * 128 + key - 128) * 2 + kvh) * 64 + ch * 8; float* ov = F.out + O_PWV + ((size_t)(b * 128 + key - 128) * 2 + kvh) * 64 + ch * 8;
            *(f32x4*)ok = (f32x4){pg8::bflo(kv.x), pg8::bfhi(kv.x), pg8::bflo(kv.y), pg8::bfhi(kv.y)}; *(f32x4*)(ok + 4) = (f32x4){pg8::bflo(kv.z), pg8::bfhi(kv.z), pg8::bflo(kv.w), pg8::bfhi(kv.w)};
            *(f32x4*)ov = (f32x4){pg8::bflo(vv.x), pg8::bfhi(vv.x), pg8::bflo(vv.y), pg8::bfhi(vv.y)}; *(f32x4*)(ov + 4) = (f32x4){pg8::bflo(vv.z), pg8::bfhi(vv.z), pg8::bflo(vv.w), pg8::bfhi(vv.w)};
        }
    }
    const int hq = kvh * 4 + (w >> 1);
    const float sink = INP(26)[hq];
    bf16x8 Qa[4], Qb[4];
#pragma unroll
    for (int i = 0; i < 4; ++i) { const bf16* qrow = Z + (size_t)(rowb + (w & 1) * 64 + 16 * i + l15) * INW + 512 + hq * 64 + 8 * quad; Qa[i] = *(const bf16x8*)qrow; Qb[i] = *(const bf16x8*)(qrow + 32); }
    __syncthreads();
#pragma unroll
    for (int i = 0; i < 4; ++i) {
        const int a = (w & 1) * 64 + 16 * i, A = a >> 4, iq = a + l15;
        const bf16x8 Q0 = Qa[i], Q1 = Qb[i];
        f32x4 s[9];
#pragma unroll
        for (int nn = 0; nn < 9; ++nn) {
            const LAS unsigned char* kp = Kl + (16 * (A + nn) + l15) * 144 + 16 * quad;
            f32x4 acc = {0.f, 0.f, 0.f, 0.f};
            acc = __builtin_amdgcn_mfma_f32_16x16x32_bf16(*(const LAS bf16x8*)kp, Q0, acc, 0, 0, 0);
            acc = __builtin_amdgcn_mfma_f32_16x16x32_bf16(*(const LAS bf16x8*)(kp + 64), Q1, acc, 0, 0, 0);
            s[nn] = acc;
        }
        float mx = sink;
#pragma unroll
        for (int nn = 0; nn < 9; ++nn) {
            if (nn == 0 || nn == 8 || qblk == 0) {
#pragma unroll
                for (int r = 0; r < 4; ++r) { const int j = 16 * (A + nn) + 4 * quad + r; const bool valid = (j >= iq) && (j <= iq + 128) && (qblk > 0 || j >= 128);
                    const float v = valid ? s[nn][r] * 0.125f : -1e30f; s[nn][r] = v; mx = fmaxf(mx, v); }
            } else {
#pragma unroll
                for (int r = 0; r < 4; ++r) { const float v = s[nn][r] * 0.125f; s[nn][r] = v; mx = fmaxf(mx, v); }
            }
        }
        mx = fmaxf(mx, xl_xor16(mx)); mx = fmaxf(mx, xl_xor32(mx));
        float sum = 0.f;
#pragma unroll
        for (int nn = 0; nn < 9; ++nn)
#pragma unroll
            for (int r = 0; r < 4; ++r) { const float e = __expf(s[nn][r] - mx); s[nn][r] = e; sum += e; }
        sum += xl_xor16(sum); sum += xl_xor32(sum);
        const float inv = 1.0f / (sum + __expf(sink - mx));
        bf16x8 P[5];
#pragma unroll
        for (int kk = 0; kk < 5; ++kk) {
            v4u pw; pw.x = pk2(s[2 * kk][0] * inv, s[2 * kk][1] * inv); pw.y = pk2(s[2 * kk][2] * inv, s[2 * kk][3] * inv);
            if (kk < 4) { pw.z = pk2(s[2 * kk + 1][0] * inv, s[2 * kk + 1][1] * inv); pw.w = pk2(s[2 * kk + 1][2] * inv, s[2 * kk + 1][3] * inv); } else { pw.z = 0u; pw.w = 0u; }
            P[kk] = __builtin_bit_cast(bf16x8, pw);
        }
        f32x4 O[4];
#pragma unroll
        for (int db = 0; db < 4; ++db) { O[db] = (f32x4){0.f, 0.f, 0.f, 0.f};
#pragma unroll
            for (int kk = 0; kk < 5; ++kk) {
                const LAS unsigned char* vp = Vl + (16 * db + l15) * 544 + (16 * (A + 2 * kk) + 4 * quad) * 2;
                const v2u lo = *(const LAS v2u*)vp, hi = *(const LAS v2u*)(vp + 32);
                const v4u vf = {lo.x, lo.y, hi.x, hi.y};
                O[db] = __builtin_amdgcn_mfma_f32_16x16x32_bf16(__builtin_bit_cast(bf16x8, vf), P[kk], O[db], 0, 0, 0);
            } }
        bf16* orow = YO + (size_t)(rowb + iq) * D + 512 + hq * 64 + 4 * quad;
#pragma unroll
        for (int db = 0; db < 4; ++db) { v2u o; o.x = pk2(O[db][0], O[db][1]); o.y = pk2(O[db][2], O[db][3]); *(v2u*)(orow + 16 * db) = o; }
    }
    __syncthreads();
}
__device__ __forceinline__ void swa_sample_unit(const Frame& F, int unit) {
    const int kvh = unit & 1, b = unit >> 1, tid = F.tid, lane = F.lane, w = F.wave;
    const bf16* Z = (const bf16*)(F.ws + WS_Z); bf16* YO = (bf16*)(F.ws + WS_CB);
    LAS float* Kf = (LAS float*)F.lds;
    LAS float* Vf = (LAS float*)(F.lds + 34320);
    LAS float* Qf = (LAS float*)(F.lds + 68112);
    LAS float* Pf = (LAS float*)(F.lds + 72208) + w * 136;
    const int rowb = NPROW + 4 * b;
    for (int idx = tid; idx < 132 * 16; idx += NTHR) {
        const int j = idx >> 4, c4 = (idx & 15) * 4;
        f32x4 kv, vv;
        if (j < 128) { kv = *(const f32x4*)(INP(4) + ((size_t)(b * 128 + j) * 2 + kvh) * 64 + c4); vv = *(const f32x4*)(INP(5) + ((size_t)(b * 128 + j) * 2 + kvh) * 64 + c4); }
        else { const bf16* zr = Z + (size_t)(rowb + j - 128) * INW; const v2u kw = *(const v2u*)(zr + 1024 + kvh * 64 + c4), vw = *(const v2u*)(zr + 1152 + kvh * 64 + c4);
            kv = (f32x4){pg8::bflo(kw.x), pg8::bfhi(kw.x), pg8::bflo(kw.y), pg8::bfhi(kw.y)}; vv = (f32x4){pg8::bflo(vw.x), pg8::bfhi(vw.x), pg8::bflo(vw.y), pg8::bfhi(vw.y)}; }
        Kf[j * 65 + c4] = kv.x; Kf[j * 65 + c4 + 1] = kv.y; Kf[j * 65 + c4 + 2] = kv.z; Kf[j * 65 + c4 + 3] = kv.w;
        *(LAS f32x4*)(Vf + j * 64 + c4) = vv;
        if (j >= 4) { *(f32x4*)(F.out + O_SWK + ((size_t)(b * 128 + j - 4) * 2 + kvh) * 64 + c4) = kv; *(f32x4*)(F.out + O_SWV + ((size_t)(b * 128 + j - 4) * 2 + kvh) * 64 + c4) = vv; }
    }
    for (int idx = tid; idx < 16 * 64; idx += NTHR) { const int qr = idx >> 6, d = idx & 63, t = qr >> 2, hl = qr & 3;
        Qf[idx] = 0.125f * bf2f(Z[(size_t)(rowb + t) * INW + 512 + (kvh * 4 + hl) * 64 + d]); }
    __syncthreads();
    const int hl = w & 3, hq = kvh * 4 + hl; const float sink = INP(26)[hq];
    for (int tt = 0; tt < 2; ++tt) {
        const int t = 2 * (w >> 2) + tt; const LAS float* q = Qf + (t * 4 + hl) * 64;
        float s[3]; float mx = sink;
#pragma unroll
        for (int cc = 0; cc < 3; ++cc) { const int j = lane + 64 * cc; float acc = 0.f;
            if (j < 132) { const LAS float* kr = Kf + j * 65;
#pragma unroll 16
                for (int d = 0; d < 64; ++d) acc += q[d] * kr[d]; }
            const bool valid = (j < 132) && (j >= t) && (j <= 128 + t); s[cc] = valid ? acc : -1e30f; mx = fmaxf(mx, s[cc]); }
        mx = wave_max(mx);
        float sum = 0.f;
#pragma unroll
        for (int cc = 0; cc < 3; ++cc) { s[cc] = __expf(s[cc] - mx); sum += s[cc]; }
        sum = wave_sum(sum);
        const float inv = 1.0f / (sum + __expf(sink - mx));
#pragma unroll
        for (int cc = 0; cc < 3; ++cc) { const int j = lane + 64 * cc; if (j < 132) Pf[j] = s[cc] * inv; }
        asm volatile("s_waitcnt lgkmcnt(0)" ::: "memory");
        float o = 0.f;
#pragma unroll 4
        for (int j = 0; j < 132; ++j) o += Pf[j] * Vf[j * 64 + lane];
        YO[(size_t)(rowb + t) * D + 512 + hq * 64 + lane] = (bf16)f2bf(o);
        asm volatile("s_waitcnt lgkmcnt(0)" ::: "memory");
    }
    __syncthreads();
}

__device__ __forceinline__ void xattn_prompt_unit(const Frame& F, int unit) {
    const int qb = unit & 31, hd = (unit >> 5) & 3, b = unit >> 7;
    const int tid = F.tid, lane = F.lane, w = F.wave, l15 = lane & 15, quad = lane >> 4;
    const bf16* Q2 = (const bf16*)(F.ws + WS_Q2); bf16* O2 = (bf16*)(F.ws + WS_O2);
    const bf16* MK = (const bf16*)(F.ws + WS_MK); const bf16* MVT = (const bf16*)(F.ws + WS_MVT);
    LAS unsigned char* L = F.lds;
    const int rowb = b * SEQ + qb * 256 + w * 32;
#pragma unroll
    for (int i = 0; i < 16; ++i) { const int idx = tid + 512 * i, key = idx >> 5, ch = idx & 31;
        *(LAS v4u*)(L + key * 528 + ch * 16) = *(const v4u*)(MK + (size_t)(b * 256 + key) * 1024 + hd * 256 + ch * 8); }
    __syncthreads();
    bf16x8 P[2][8];
#pragma unroll
    for (int qi = 0; qi < 2; ++qi) {
        const bf16* qrow = Q2 + (size_t)(rowb + qi * 16 + l15) * D + hd * 256 + 8 * quad;
        bf16x8 Qf[8];
#pragma unroll
        for (int ks = 0; ks < 8; ++ks) Qf[ks] = *(const bf16x8*)(qrow + 32 * ks);
        f32x4 s[16]; float mx = -1e30f;
#pragma unroll
        for (int kb = 0; kb < 16; ++kb) { f32x4 acc = {0.f, 0.f, 0.f, 0.f}; const LAS unsigned char* kp = L + (16 * kb + l15) * 528 + 16 * quad;
#pragma unroll
            for (int ks = 0; ks < 8; ++ks) acc = __builtin_amdgcn_mfma_f32_16x16x32_bf16(*(const LAS bf16x8*)(kp + 64 * ks), Qf[ks], acc, 0, 0, 0);
            s[kb] = acc; mx = fmaxf(fmaxf(mx, fmaxf(acc[0], acc[1])), fmaxf(acc[2], acc[3])); if (kb & 1) __builtin_amdgcn_sched_barrier(0); }
        mx = fmaxf(mx, xl_xor16(mx)); mx = fmaxf(mx, xl_xor32(mx));
        float sum = 0.f;
#pragma unroll
        for (int kb = 0; kb < 16; ++kb)
#pragma unroll
            for (int r = 0; r < 4; ++r) { const float e = __expf((s[kb][r] - mx) * 0.0625f); s[kb][r] = e; sum += e; }
        sum += xl_xor16(sum); sum += xl_xor32(sum);
        const float inv = 1.0f / sum;
#pragma unroll
        for (int kk = 0; kk < 8; ++kk) { v4u pw; pw.x = pk2(s[2 * kk][0] * inv, s[2 * kk][1] * inv); pw.y = pk2(s[2 * kk][2] * inv, s[2 * kk][3] * inv);
            pw.z = pk2(s[2 * kk + 1][0] * inv, s[2 * kk + 1][1] * inv); pw.w = pk2(s[2 * kk + 1][2] * inv, s[2 * kk + 1][3] * inv); P[qi][kk] = __builtin_bit_cast(bf16x8, pw); }
    }
    __syncthreads();
#pragma unroll
    for (int i = 0; i < 16; ++i) { const int idx = tid + 512 * i, d = idx >> 5, ch = idx & 31;
        *(LAS v4u*)(L + d * 528 + ch * 16) = *(const v4u*)(MVT + ((size_t)(b * 4 + hd) * 256 + d) * 256 + ch * 8); }
    __syncthreads();
#pragma unroll
    for (int qi = 0; qi < 2; ++qi) {
        f32x4 O[16];
#pragma unroll
        for (int db = 0; db < 16; ++db) O[db] = (f32x4){0.f, 0.f, 0.f, 0.f};
#pragma unroll
        for (int kk = 0; kk < 8; ++kk) {
#pragma unroll
            for (int db = 0; db < 16; ++db) { const LAS unsigned char* vp = L + (16 * db + l15) * 528 + (32 * kk + 4 * quad) * 2;
                const v2u lo = *(const LAS v2u*)vp, hi = *(const LAS v2u*)(vp + 32); const v4u vf = {lo.x, lo.y, hi.x, hi.y};
                O[db] = __builtin_amdgcn_mfma_f32_16x16x32_bf16(__builtin_bit_cast(bf16x8, vf), P[qi][kk], O[db], 0, 0, 0);
                if ((db & 7) == 7) __builtin_amdgcn_sched_barrier(0); } }
        bf16* orow = O2 + (size_t)(rowb + qi * 16 + l15) * D + hd * 256 + 4 * quad;
#pragma unroll
        for (int db = 0; db < 16; ++db) { v2u o; o.x = pk2(O[db][0], O[db][1]); o.y = pk2(O[db][2], O[db][3]); *(v2u*)(orow + 16 * db) = o; }
    }
    __syncthreads();
}
__device__ __forceinline__ void xattn_sample_unit(const Frame& F, int unit) {
    const int hd = unit & 3, b = unit >> 2, tid = F.tid, lane = F.lane, w = F.wave;
    const bf16* Q2 = (const bf16*)(F.ws + WS_Q2); bf16* O2 = (bf16*)(F.ws + WS_O2);
    LAS float* OP = (LAS float*)F.lds;
    LAS float* ML = (LAS float*)(F.lds + 32768);
    const int rowb = NPROW + 4 * b;
    f32x4 q[4];
#pragma unroll
    for (int t = 0; t < 4; ++t) {
        const float* c0 = (const float*)(F.ws + WS_CS) + (size_t)(4 * b + t) * D + hd * 256 + 4 * lane;
        q[t] = (*(const f32x4*)c0 + *(const f32x4*)(c0 + 512 * 1024)) * ((const float*)(F.ws + WS_RS))[(size_t)2 * M + rowb + t]; }
    const float* kbase = INP(6) + ((size_t)(b * 256 + w * 32) * 4 + hd) * 256 + 4 * lane;
    const float* vbase = INP(7) + ((size_t)(b * 256 + w * 32) * 4 + hd) * 256 + 4 * lane;
    float scb[2];
#pragma unroll
    for (int bb = 0; bb < 2; ++bb) {
        float v[64];
#pragma unroll
        for (int i = 0; i < 16; ++i) { const f32x4 kv = *(const f32x4*)(kbase + (size_t)(16 * bb + i) * 1024);
#pragma unroll
            for (int t = 0; t < 4; ++t) v[4 * i + t] = (q[t].x * kv.x + q[t].y * kv.y) + (q[t].z * kv.z + q[t].w * kv.w); }
        const bool b0 = lane & 1, b1 = lane & 2, b2 = lane & 4, b3 = lane & 8, b4 = lane & 16, b5 = lane & 32;
#pragma unroll
        for (int j = 0; j < 32; ++j) { const float a = v[2 * j], c = v[2 * j + 1]; v[j] = (b0 ? c : a) + xl_dpp_b1(b0 ? a : c); }
#pragma unroll
        for (int j = 0; j < 16; ++j) { const float a = v[2 * j], c = v[2 * j + 1]; v[j] = (b1 ? c : a) + xl_dpp_4e(b1 ? a : c); }
#pragma unroll
        for (int j = 0; j < 8; ++j) { const float a = v[2 * j], c = v[2 * j + 1]; v[j] = (b2 ? c : a) + __shfl_xor(b2 ? a : c, 4); }
#pragma unroll
        for (int j = 0; j < 4; ++j) { const float a = v[2 * j], c = v[2 * j + 1]; v[j] = (b3 ? c : a) + __shfl_xor(b3 ? a : c, 8); }
#pragma unroll
        for (int j = 0; j < 2; ++j) { const float a = v[2 * j], c = v[2 * j + 1]; v[j] = (b4 ? c : a) + xl_xor16(b4 ? a : c); }
        scb[bb] = ((b5 ? v[1] : v[0]) + xl_xor32(b5 ? v[0] : v[1])) * 0.0625f;
    }
    f32x4 vpre[8];
#pragma unroll
    for (int i = 0; i < 8; ++i) vpre[i] = *(const f32x4*)(vbase + (size_t)i * 1024);
    float mq = fmaxf(scb[0], scb[1]);
    mq = fmaxf(mq, __shfl_xor(mq, 4)); mq = fmaxf(mq, __shfl_xor(mq, 8)); mq = fmaxf(mq, xl_xor16(mq)); mq = fmaxf(mq, xl_xor32(mq));
    float e0 = __expf(scb[0] - mq), e1 = __expf(scb[1] - mq);
    float lq = e0 + e1;
    lq += __shfl_xor(lq, 4); lq += __shfl_xor(lq, 8); lq += xl_xor16(lq); lq += xl_xor32(lq);
    float mloc[4], lloc[4];
#pragma unroll
    for (int t = 0; t < 4; ++t) { mloc[t] = __uint_as_float(__builtin_amdgcn_readlane(__float_as_uint(mq), t)); lloc[t] = __uint_as_float(__builtin_amdgcn_readlane(__float_as_uint(lq), t)); }
    f32x4 o[4];
#pragma unroll
    for (int t = 0; t < 4; ++t) o[t] = (f32x4){0.f, 0.f, 0.f, 0.f};
#pragma unroll
    for (int i = 0; i < 32; ++i) {
        const f32x4 vv = i < 8 ? vpre[i] : *(const f32x4*)(vbase + (size_t)i * 1024);
#pragma unroll
        for (int t = 0; t < 4; ++t) { const float pp = __uint_as_float(__builtin_amdgcn_readlane(__float_as_uint(i < 16 ? e0 : e1), 4 * (i & 15) + t)); o[t] = o[t] + vv * pp; } }
#pragma unroll
    for (int t = 0; t < 4; ++t) { *(LAS f32x4*)(OP + (w * 4 + t) * 256 + 4 * lane) = o[t]; if (lane == 0) { ML[(w * 4 + t) * 2] = mloc[t]; ML[(w * 4 + t) * 2 + 1] = lloc[t]; } }
    __syncthreads();
#pragma unroll
    for (int k = 0; k < 2; ++k) { const int idx = tid + 512 * k, t = idx >> 8, d = idx & 255;
        float mm = -1e30f;
#pragma unroll
        for (int ww = 0; ww < 8; ++ww) mm = fmaxf(mm, ML[(ww * 4 + t) * 2]);
        float L = 0.f, acc = 0.f;
#pragma unroll
        for (int ww = 0; ww < 8; ++ww) { const float f = __expf(ML[(ww * 4 + t) * 2] - mm); L += ML[(ww * 4 + t) * 2 + 1] * f; acc += OP[(ww * 4 + t) * 256 + d] * f; }
        O2[(size_t)(rowb + t) * D + hd * 256 + d] = (bf16)f2bf(acc / L); }
    __syncthreads();
}

#define XB_TMO      128
#define XB_XCNT(j)  (256  + 64 * (j))
#define XB_XSUB(j)  (1280 + 64 * (j))
#define XB_XGEN(j)  (2304 + 64 * (j))
#define XB_TOP      3328
#define XB_TOPGEN   3392
#define XCD_BAR_WORDS 3456
#define XB_SPIN_CAP (1u << 18)

__device__ __forceinline__ unsigned xb_ld(unsigned* p)              { return __hip_atomic_load(p, __ATOMIC_RELAXED, __HIP_MEMORY_SCOPE_AGENT); }
__device__ __forceinline__ unsigned xb_add(unsigned* p, unsigned v) { return __hip_atomic_fetch_add(p, v, __ATOMIC_RELAXED, __HIP_MEMORY_SCOPE_AGENT); }
__device__ __forceinline__ unsigned xb_xcc_id() { return (unsigned)__builtin_amdgcn_s_getreg((3 << 11) | 20) & 0xFu; }
#define XB_SPIN(cond, bar) do { unsigned _sp = 0; while (cond) { __builtin_amdgcn_s_sleep(1); \
    if ((++_sp & 255u) == 0u) { if (xb_ld(&(bar)[XB_TMO])) break; if (_sp > XB_SPIN_CAP) { atomicAdd(&(bar)[XB_TMO], 1u); break; } } } } while (0)

struct XcdBarrier {
    unsigned* bar; unsigned x;
    volatile LAS unsigned* st;
};

__device__ __forceinline__ XcdBarrier xcd_barrier_post(unsigned* bar, volatile LAS unsigned* st) {
    XcdBarrier b; b.bar = bar; b.x = xb_xcc_id(); b.st = st;
    if (threadIdx.x == 0) (void)xb_add(&bar[XB_XCNT(b.x)], 1u);
    return b;
}
__device__ __forceinline__ void xcd_barrier_complete(unsigned* bar, unsigned x, unsigned& nloc, unsigned& nx) {
    const unsigned G = gridDim.x * gridDim.y * gridDim.z;
    unsigned sum, cnt, mine, sp = 0u;
    for (;;) {
        sum = 0u; cnt = 0u; mine = 0u;
#pragma unroll
        for (unsigned j = 0; j < 16; ++j) { const unsigned c = xb_ld(&bar[XB_XCNT(j)]); sum += c; cnt += (c > 0u) ? 1u : 0u; mine = (j == x) ? c : mine; }
        if (sum == G) break;
        __builtin_amdgcn_s_sleep(1);
        if ((++sp & 255u) == 0u) { if (xb_ld(&bar[XB_TMO])) break; if (sp > XB_SPIN_CAP) { atomicAdd(&bar[XB_TMO], 1u); break; } }
    }
    nloc = mine > 0u ? mine : 1u; nx = cnt > 0u ? cnt : 1u;
}

__device__ __forceinline__ void xcd_barrier(const XcdBarrier& b) {
    asm volatile("s_waitcnt vmcnt(0)" ::: "memory");
    __syncthreads();
    if (threadIdx.x == 0) {
        unsigned* bar = b.bar;
        __builtin_amdgcn_s_waitcnt(0);
        unsigned nloc = b.st[0], nx = b.st[1];
        if (nloc == 0u) { xcd_barrier_complete(bar, b.x, nloc, nx); b.st[0] = nloc; b.st[1] = nx; }
        const unsigned old = xb_add(&bar[XB_XSUB(b.x)], 1u);
        const unsigned gen = old / nloc;
        if (old + 1u == (gen + 1u) * nloc) {
            __builtin_amdgcn_fence(__ATOMIC_RELEASE, "agent");
            asm volatile("s_waitcnt vmcnt(0)" ::: "memory");
            const unsigned og = xb_add(&bar[XB_TOP], 1u);
            const unsigned tg = og / nx;
            if (og + 1u == (tg + 1u) * nx) xb_add(&bar[XB_TOPGEN], 1u);
            else XB_SPIN(xb_ld(&bar[XB_TOPGEN]) == tg, bar);
            __builtin_amdgcn_fence(__ATOMIC_ACQUIRE, "agent");
            xb_add(&bar[XB_XGEN(b.x)], 1u);
            asm volatile("s_waitcnt vmcnt(0)" ::: "memory");
        } else {
            XB_SPIN(xb_ld(&bar[XB_XGEN(b.x)]) == gen, bar);
            __builtin_amdgcn_fence(__ATOMIC_ACQUIRE, "agent");
            asm volatile("s_waitcnt vmcnt(0)" ::: "memory");
        }
    }
    __syncthreads();
}

__device__ __forceinline__ void run_gu(const Frame& F, size_t woff, int rsi, int cid) {
    pg8::Gemm g{(const bf16*)(F.ws + WS_HB), (const bf16*)(F.ws + woff), M, 2 * FF, D}; pg8::StaticOrder S; S.init(M, 2 * FF, F.G, cid);
    pg8::EpiSwiglu E{(bf16*)(F.ws + WS_ACT), FF, (const float*)(F.ws + WS_RS) + (size_t)rsi * M};
    pg8::gemm_phase<pg8::EpiSwiglu, pg8::StaticOrder, true, true>(F.lds, g, S, E);
}
__device__ __forceinline__ void run_plain(const Frame& F, size_t aoff, size_t boff, size_t ooff, int K, int rsi, int cid) {
    pg8::Gemm g{(const bf16*)(F.ws + aoff), (const bf16*)(F.ws + boff), M, D, K}; pg8::StaticOrder S; S.init(M, D, F.G, cid);
    pg8::EpiPlain E{(bf16*)(F.ws + ooff), D, (const float*)(F.ws + WS_RS) + (size_t)rsi * M};
    pg8::gemm_phase<pg8::EpiPlain, pg8::StaticOrder, true, true>(F.lds, g, S, E);
}

__device__ __forceinline__ void run_gemm_ew(const Frame& F, size_t aoff, size_t boff, int K, int which, const float* gpost, float wgt, bool final, int cid) {
    const int vc = (F.G % 8 == 0) ? (cid % 8) * (F.G / 8) + cid / 8 : cid;
    unsigned* cntP = (unsigned*)(F.ws + CTL_CNT) + (size_t)which * (130 * 64);
    unsigned* cntB = cntP + 128 * 64;
    { pg8::Gemm g{(const bf16*)(F.ws + aoff), (const bf16*)(F.ws + boff), NPROW, D, K, K}; pg8::PanelOrder S; S.init(NPROW, F.G, vc);
      pg8::EpiPlainCnt E{(bf16*)(F.ws + WS_CB), D, cntP, cntB};
      pg8::gemm_phase<pg8::EpiPlainCnt, pg8::PanelOrder, true, true>(F.lds, g, S, E); }
    const bool late = (vc & 7) == 0; const int li = vc >> 3;
    if (late) {
        const int part = li & 3, nt = K / 64, q2 = (nt / 4) & ~1, big = (nt - 4 * q2) / 2;
        const int len = (part < big ? q2 + 2 : q2) * 64, k0 = (part * q2 + 2 * (part < big ? part : big)) * 64;
        pg8::Gemm g{(const bf16*)(F.ws + aoff), (const bf16*)(F.ws + boff), M, D, len, K}; pg8::SampleSplit4Order S{li, k0};
        pg8::EpiPart4F32 E{(float*)(F.ws + WS_CS4), part, cntB};
        pg8::gemm_phase<pg8::EpiPart4F32, pg8::SampleSplit4Order, true, true>(F.lds, g, S, E); }
    float* rs_out = (float*)(F.ws + WS_RS) + (size_t)(which + 1) * M;
    const int p0 = vc >> 2, p1 = (F.G + vc) >> 2;
    if (F.tid == 0) { unsigned sp = 0;
        while (__hip_atomic_load(cntP + 64 * p0, __ATOMIC_RELAXED, __HIP_MEMORY_SCOPE_AGENT) < 4u || __hip_atomic_load(cntP + 64 * p1, __ATOMIC_RELAXED, __HIP_MEMORY_SCOPE_AGENT) < 4u) { __builtin_amdgcn_s_sleep(4); if (++sp > (1u << 24)) break; }
        __builtin_amdgcn_fence(__ATOMIC_ACQUIRE, "agent"); asm volatile("s_waitcnt vmcnt(0)" ::: "memory"); }
    __syncthreads();
    if (!late) {
        const int q = vc & 3;
        ew_rows<false>(F, (const bf16*)(F.ws + WS_CB), gpost, wgt, final, rs_out, p0 * 256 + q * 64, p0 * 256 + q * 64 + 64, F.wave, NWAVES);
        ew_rows<false>(F, (const bf16*)(F.ws + WS_CB), gpost, wgt, final, rs_out, p1 * 256 + q * 64, p1 * 256 + q * 64 + 64, F.wave, NWAVES);
        if ((vc & 4) == 0) {
            ew_rows<false>(F, (const bf16*)(F.ws + WS_CB), gpost, wgt, final, rs_out, p0 * 256, p0 * 256 + 64, (q - 1) + 3 * F.wave, 3 * NWAVES);
            ew_rows<false>(F, (const bf16*)(F.ws + WS_CB), gpost, wgt, final, rs_out, p1 * 256, p1 * 256 + 64, (q - 1) + 3 * F.wave, 3 * NWAVES);
        }
    }
    if (late) {
        if (F.tid == 0) { unsigned sp = 0; while (__hip_atomic_load(cntB, __ATOMIC_RELAXED, __HIP_MEMORY_SCOPE_AGENT) < 32u) { __builtin_amdgcn_s_sleep(4); if (++sp > (1u << 24)) break; }
            __builtin_amdgcn_fence(__ATOMIC_ACQUIRE, "agent"); asm volatile("s_waitcnt vmcnt(0)" ::: "memory"); }
        __syncthreads();
        ew_rows<true>(F, (const bf16*)(F.ws + WS_CB), gpost, wgt, final, rs_out, NPROW, M, li * NWAVES + F.wave, 32 * NWAVES);
    }
}
__device__ __forceinline__ void convert_ffn2_weights(const Frame& F, int widx, int nw) {
    LAS float* scr = (LAS float*)(F.lds + F.wave * 16384);
    constexpr int I_GU = (D / 64) * (FF / 32), I_DN = (FF / 64) * (D / 32);
    for (int it = widx; it < 2 * I_GU + I_DN; it += nw) {
        int r = it;
        if (r < I_GU) { p0_transpose_item(INP(39), D, FF, (bf16*)(F.ws + WS_W2GU), 0, 1, scr, r, F.lane, INP(38)); continue; } r -= I_GU;
        if (r < I_GU) { p0_transpose_item(INP(40), D, FF, (bf16*)(F.ws + WS_W2GU), 0, 2, scr, r, F.lane, INP(38)); continue; } r -= I_GU;
        p0_transpose_item(INP(41), FF, D, (bf16*)(F.ws + WS_W2D), 0, 0, scr, r, F.lane);
    }
}
enum { PH_P0 = 0, PH_GU1, PH_DN1, PH_WIN, PH_MIXA, PH_SSM2, PH_GLU, PH_WOUT, PH_MEMQ, PH_XATT, PH_MEMO, PH_GU2, PH_DN2, PH_COUNT };

__global__ void __launch_bounds__(NTHR, 2) fwd_megakernel(Args args) {
    extern __shared__ __attribute__((aligned(16))) unsigned char lds_raw[];
    cg::grid_group grid = cg::this_grid();
    Frame F;
    F.lds = (LAS unsigned char*)lds_raw;
    F.tid = threadIdx.x; F.lane = F.tid & 63; F.wave = __builtin_amdgcn_readfirstlane(F.tid >> 6); F.G = gridDim.x;
    F.in = args.in; F.out = args.out; F.ws = args.ws;
    unsigned char* ws = args.ws;
    const int cid = (int)blockIdx.x;
    volatile LAS unsigned* MISC = (volatile LAS unsigned*)(F.lds + LDS_BYTES - 256);
    if (F.tid < 64) MISC[F.tid] = 0u;
    __syncthreads();
    XcdBarrier bar = xcd_barrier_post((unsigned*)ws, MISC + 8);
    const int lo = args.ph_lo, hi = args.ph_hi;
#define IN_PH(k) (lo <= (k) && (k) < hi)
#define SEAM(k) do { if (IN_PH(k) && IN_PH((k) + 1)) xcd_barrier(bar); } while (0)
    if (hi > PH_COUNT) grid.sync();
    if (IN_PH(PH_P0)) p0_prologue(F);
    SEAM(PH_P0);
    if (IN_PH(PH_GU1)) {
        run_gu(F, WS_W1GU, 0, cid);
        const int nlast = (M / 256) * (2 * FF / 256) % F.G;
        if (cid >= nlast && cid < nlast + 32) {
            pg8::Gemm g{(const bf16*)(ws + WS_MN), (const bf16*)(ws + WS_WMKV), 1024, 2048, D}; pg8::StaticOrder S; S.init(1024, 2048, F.G, cid - nlast);
            pg8::EpiMemKV E{F.out + O_PMK, F.out + O_PMV, (bf16*)(ws + WS_MK), (bf16*)(ws + WS_MVT)};
            pg8::gemm_phase<pg8::EpiMemKV, pg8::StaticOrder, true, true>(F.lds, g, S, E);
        } else if (cid >= nlast + 32) convert_ffn2_weights(F, (cid - nlast - 32) * NWAVES + F.wave, (F.G - nlast - 32) * NWAVES);
    }
    SEAM(PH_GU1);
    if (IN_PH(PH_DN1)) run_gemm_ew(F, WS_ACT, WS_W1D, FF, 0, INP(13), 0.5f, false, cid);
    SEAM(PH_DN1);
    if (IN_PH(PH_WIN)) {
        { pg8::Gemm g{(const bf16*)(ws + WS_HB), (const bf16*)(ws + WS_WIN), M, INW, D}; pg8::StaticOrder S; S.init(M, INW, F.G, cid);
          pg8::EpiWin E{(bf16*)(ws + WS_Z), (const float2*)(ws + WS_ROPE), (const float*)(ws + WS_RS) + (size_t)1 * M};
          pg8::gemm_phase<pg8::EpiWin, pg8::StaticOrder, true, true>(F.lds, g, S, E); }
    }
    SEAM(PH_WIN);
    if (IN_PH(PH_MIXA)) {
        { const int vcw = (F.G % 8 == 0) ? (cid % 8) * (F.G / 8) + cid / 8 : cid; for (int u = vcw; u < 512; u += F.G) swa_prompt_unit(F, u); }
        for (int u = cid; u < 256; u += F.G) swa_sample_unit(F, u);
        ssm_pass1(F);
    }
    SEAM(PH_MIXA);
    if (IN_PH(PH_SSM2)) ssm_pass2(F);
    SEAM(PH_SSM2);
    if (IN_PH(PH_GLU)) {
        const int vc = (F.G % 8 == 0) ? (cid % 8) * (F.G / 8) + cid / 8 : cid;
        unsigned* cnt = (unsigned*)(ws + CTL_CNT) + (size_t)5 * (130 * 64);
        const bool late = (vc & 63) == 0; const int li = vc >> 6;
        { pg8::Gemm g{(const bf16*)(ws + WS_G), (const bf16*)(ws + WS_WGLU), NPROW, 512, 512, 512}; pg8::PanelOrder2 S{vc};
          pg8::EpiGlu E{(const bf16*)(ws + WS_G), INP(25), (bf16*)(ws + WS_CB), D, cnt};
          pg8::gemm_phase<pg8::EpiGlu, pg8::PanelOrder2, true, true>(F.lds, g, S, E); }
        if (late) { pg8::Gemm g{(const bf16*)(ws + WS_G), (const bf16*)(ws + WS_WGLU), M, 512, 512, 512}; pg8::OneUnitOrder S{128 + (li >> 1), li & 1};
          pg8::EpiGlu E{(const bf16*)(ws + WS_G), INP(25), (bf16*)(ws + WS_CB), D, cnt};
          pg8::gemm_phase<pg8::EpiGlu, pg8::OneUnitOrder, true, true>(F.lds, g, S, E); }
        const int pmw = late ? 128 + (li >> 1) : (vc >> 1);
        if (F.tid == 0) { unsigned sp = 0; while (__hip_atomic_load(cnt + 64 * pmw, __ATOMIC_RELAXED, __HIP_MEMORY_SCOPE_AGENT) < 2u) { __builtin_amdgcn_s_sleep(4); if (++sp > (1u << 24)) break; }
            __builtin_amdgcn_fence(__ATOMIC_ACQUIRE, "agent"); asm volatile("s_waitcnt vmcnt(0)" ::: "memory"); }
        __syncthreads();
        if (late) mix_rows(F, pmw * 256 + (li & 1) * 128, pmw * 256 + (li & 1) * 128 + 128, F.wave, NWAVES);
        else if ((vc & 63) == 1) mix_rows(F, pmw * 256, pmw * 256 + 256, F.wave, NWAVES);
        else mix_rows(F, pmw * 256 + (vc & 1) * 128, pmw * 256 + (vc & 1) * 128 + 128, F.wave, NWAVES);
    }
    SEAM(PH_GLU);
    if (IN_PH(PH_WOUT)) run_gemm_ew(F, WS_XN, WS_WOUT, D, 1, INP(30), 1.0f, false, cid);
    SEAM(PH_WOUT);
    if (IN_PH(PH_MEMQ)) {
        const int vc = (F.G % 8 == 0) ? (cid % 8) * (F.G / 8) + cid / 8 : cid;
        if ((vc & 15) == 0) { pg8::Gemm g{(const bf16*)(ws + WS_HB), (const bf16*)(ws + WS_WMQ), M, D, D / 2, D}; pg8::SampleSplitOrder S{vc >> 4, D / 2};
          pg8::EpiPartF32 E{(float*)(ws + WS_CS), D / 2, (unsigned*)(ws + CTL_CNT) + (size_t)4 * (130 * 64)};
          pg8::gemm_phase<pg8::EpiPartF32, pg8::SampleSplitOrder, true, true>(F.lds, g, S, E); }
        { pg8::Gemm g{(const bf16*)(ws + WS_HB), (const bf16*)(ws + WS_WMQ), NPROW, D, D, D}; pg8::StaticOrder S; S.init(NPROW, D, F.G, cid);
          pg8::EpiPlain E{(bf16*)(ws + WS_Q2), D, (const float*)(ws + WS_RS) + (size_t)2 * M};
          pg8::gemm_phase<pg8::EpiPlain, pg8::StaticOrder, true, true>(F.lds, g, S, E); }
    }
    SEAM(PH_MEMQ);
    if (IN_PH(PH_XATT)) {
        const int vcx = (F.G % 8 == 0) ? (cid % 8) * (F.G / 8) + cid / 8 : cid;
        if (vcx & 1) { for (int u = cid; u < 512; u += F.G) xattn_sample_unit(F, u); for (int u = vcx; u < 512; u += F.G) xattn_prompt_unit(F, u); }
        else { for (int u = vcx; u < 512; u += F.G) xattn_prompt_unit(F, u); for (int u = cid; u < 512; u += F.G) xattn_sample_unit(F, u); }
    }
    SEAM(PH_XATT);
    if (IN_PH(PH_MEMO)) run_gemm_ew(F, WS_O2, WS_WMO, D, 2, INP(37), 1.0f, false, cid);
    SEAM(PH_MEMO);
    if (IN_PH(PH_GU2)) run_gu(F, WS_W2GU, 3, cid);
    SEAM(PH_GU2);
    if (IN_PH(PH_DN2)) run_gemm_ew(F, WS_ACT, WS_W2D, FF, 3, INP(42), 0.5f, true, cid);
}

extern "C" void kernel_launch(void* const* d_in, const int* in_sizes, int n_in, void* d_out, int out_size, void* d_ws, size_t ws_size, hipStream_t stream) {
    static int grid = 0;
    if (grid == 0) {
        if (n_in != 43 || out_size != (int)O_END || ws_size < WS_END2) { fprintf(stderr, "kernel_launch: unexpected sizes n_in %d out %d ws %zu\n", n_in, out_size, ws_size); grid = -1; return; }
        int dev = 0, cus = 0, per_cu = 0;
        hipGetDevice(&dev); hipDeviceGetAttribute(&cus, hipDeviceAttributeMultiprocessorCount, dev);
        hipFuncSetAttribute((const void*)fwd_megakernel, hipFuncAttributeMaxDynamicSharedMemorySize, LDS_BYTES);
        hipOccupancyMaxActiveBlocksPerMultiprocessor(&per_cu, (const void*)fwd_megakernel, NTHR, LDS_BYTES);
        if (per_cu < 1) { fprintf(stderr, "kernel_launch: occupancy query says %d blocks/CU\n", per_cu); per_cu = 1; }
        (void)hipGetLastError();
        grid = cus;
    }
    if (grid < 0) return;
    if (hipMemsetAsync(d_ws, 0, CTL_ZERO, stream) != hipSuccess) { fprintf(stderr, "kernel_launch: memset failed\n"); return; }
    Args a{};
    for (int i = 0; i < 43; ++i) a.in[i] = (const float*)d_in[i];
    a.out = (float*)d_out; a.ws = (unsigned char*)d_ws; a.ph_lo = 0; a.ph_hi = PH_COUNT;
    void* kargs[] = {&a};
    hipError_t e = hipLaunchCooperativeKernel((const void*)fwd_megakernel, dim3(grid), dim3(NTHR), kargs, LDS_BYTES, stream);
    if (e != hipSuccess) fprintf(stderr, "cooperative launch failed: %s (grid %d)\n", hipGetErrorString(e), grid);
}
```

```cpp
#include <hip/hip_runtime.h>
#include <cstdio>
#include <cstdint>
namespace pg8 {
#define PG8_LAS __attribute__((address_space(3)))
typedef unsigned short bf16_t;
typedef short bf16x8 __attribute__((ext_vector_type(8)));
typedef float f32x4 __attribute__((ext_vector_type(4)));
typedef unsigned u32x4 __attribute__((ext_vector_type(4)));
constexpr int BM = 256, BK = 64, HALF = 128, HTB = HALF * BK * 2  , STAGE_BYTES = 8 * HTB, NXCD = 8, WGM = 8;

__host__ __device__ __forceinline__ int lds_byte(int r, int c) { const int st = (r >> 4) * 2 + (c >> 5), rr = r & 15, cc = c & 31, ob = rr * 64 + cc * 2; return st * 1024 + (ob ^ (((ob >> 9) & 1) << 5)); }
__host__ __device__ __forceinline__ void stage_rc(int b, int& R, int& C) { const int st = b / 1024, sb = b % 1024, swz = sb ^ (((sb >> 9) & 1) << 5); R = (st >> 1) * 16 + swz / 64; C = (st & 1) * 32 + (swz % 64) / 2; }
__host__ __device__ __forceinline__ int perm32(int rho) { const int n = rho >> 4, i = rho & 15; return 8 * (i >> 2) + 4 * n + (i & 3); }

struct Unit { int pm, pn, k0 = 0; };
struct Gemm { const bf16_t* A; const bf16_t* Bt; int M, N, K, ld; };

struct StaticOrder {
    int nM, nN, nwg, G, c;
    __host__ __device__ void init(int M, int N, int G_, int c_) { nM = M / BM; nN = N / BM; nwg = nM * nN; G = G_; c = c_; }
    __host__ __device__ bool next(int i, Unit& u) const {
        const long L = (long)i * G + c; if (L >= nwg) return false;
        int wgid = (int)L; { const int q = nwg / NXCD, r = nwg % NXCD, xcd = wgid % NXCD, off = wgid / NXCD; wgid = (xcd < r ? xcd * (q + 1) : r * (q + 1) + (xcd - r) * q) + off; }
        const int nig = WGM * nN, gid = wgid / nig, fm = gid * WGM, gsz = (nM - fm) < WGM ? (nM - fm) : WGM;
        u.pm = fm + ((wgid % nig) % gsz); u.pn = (wgid % nig) / gsz; return true;
    }
    __device__ __forceinline__ void a_ready(const Unit&) const {}
    __device__ __forceinline__ void done(const Unit&) const {}
};

__device__ __forceinline__ unsigned cvt_pk_bf16(float lo, float hi) { unsigned r; asm volatile("v_cvt_pk_bf16_f32 %0, %1, %2" : "=v"(r) : "v"(lo), "v"(hi)); return r; }
typedef float f32x2 __attribute__((ext_vector_type(2)));
__device__ __forceinline__ f32x2 gelu_pk(f32x2 v) {
    const f32x2 av = __builtin_elementwise_abs(v), d = av * 0.2316418882f + 1.0f;
    f32x2 t; t.x = __builtin_amdgcn_rcpf(d.x); t.y = __builtin_amdgcn_rcpf(d.y);
    f32x2 q = t * 0.5307027145f + (-0.7265760135f); q = q * t + 0.7107068705f; q = q * t + (-0.142248368f); q = q * t + 0.127414796f; q = q * t;
    const f32x2 s = (v * v) * (-0.72134752044f);
    f32x2 e; e.x = __builtin_amdgcn_exp2f(s.x); e.y = __builtin_amdgcn_exp2f(s.y);
    const f32x2 m = v * (q * e), r = v - m;
    f32x2 o; o.x = v.x < 0.f ? m.x : r.x; o.y = v.y < 0.f ? m.y : r.y; return o;
}

template <int ACT  > struct EpiBf16 {
    static constexpr bool PERM = true, AFTER_DRAIN = false; static_assert(ACT == 0 || ACT == 1, "EpiBf16: ACT is 0 (none) or 1 (gelu_pk)");
    bf16_t* O; int ldc; const float* bias; int split_cols; size_t split_stride; float scale0;
    __device__ __forceinline__ void operator()(const f32x4 (&acc)[2][2][4][2], const Unit& u, int wr, int wc, int fr, int fq) const {
        const int row0 = u.pm * BM + wr * 64 + fr; int colt = u.pn * BM; bf16_t* base = O;
        float sc = 1.f; if (split_cols) { const int t = colt / split_cols; base += (size_t)t * split_stride; colt -= t * split_cols; if (t == 0) sc = scale0; }
        const int col0 = colt + wc * 32 + 8 * fq, bcol0 = u.pn * BM + wc * 32 + 8 * fq;
        f32x4 bv[2][2];
#pragma unroll
        for (int bj = 0; bj < 2; ++bj)
#pragma unroll
            for (int n = 0; n < 2; ++n) bv[bj][n] = bias ? *(const f32x4*)(bias + bcol0 + bj * HALF + 4 * n) : (f32x4){0.f, 0.f, 0.f, 0.f};
#pragma unroll
        for (int ai = 0; ai < 2; ++ai)
#pragma unroll
            for (int m = 0; m < 4; ++m) { bf16_t* rowp = base + (size_t)(row0 + ai * HALF + m * 16) * ldc + col0;
#pragma unroll
                for (int bj = 0; bj < 2; ++bj) { f32x4 v0 = acc[ai][bj][m][0] + bv[bj][0], v1 = acc[ai][bj][m][1] + bv[bj][1];
                    if (ACT == 1) { f32x2 a = gelu_pk((f32x2){v0[0], v0[1]}), b = gelu_pk((f32x2){v0[2], v0[3]}), c = gelu_pk((f32x2){v1[0], v1[1]}), d = gelu_pk((f32x2){v1[2], v1[3]});
                        v0 = (f32x4){a.x, a.y, b.x, b.y}; v1 = (f32x4){c.x, c.y, d.x, d.y}; }
                    v0 = v0 * sc; v1 = v1 * sc; u32x4 w; w.x = cvt_pk_bf16(v0[0], v0[1]); w.y = cvt_pk_bf16(v0[2], v0[3]); w.z = cvt_pk_bf16(v1[0], v1[1]); w.w = cvt_pk_bf16(v1[2], v1[3]);
                    *(u32x4*)(rowp + bj * HALF) = w; } }
    }
};

struct PanelStats {
    unsigned* xbuf;
    unsigned* cnt;
    unsigned* tmo;
    int ntn; float eps;
    unsigned code;
    __device__ __forceinline__ bool run(const f32x4 (&v)[2][2][4][2], const Unit& u, int wr, int wc, int fr, int fq, PG8_LAS unsigned char* lds, int wid, int lane) const {
        typedef float f32x2v __attribute__((ext_vector_type(2)));
        PG8_LAS f32x2v* P = (PG8_LAS f32x2v*)lds;
        PG8_LAS f32x2v* S = (PG8_LAS f32x2v*)(lds + 8192);
        PG8_LAS unsigned* flag = (PG8_LAS unsigned*)(lds + 8192 + 2048);
#pragma unroll
        for (int ai = 0; ai < 2; ++ai)
#pragma unroll
            for (int m = 0; m < 4; ++m) {
                float s = 0.f;
#pragma unroll
                for (int bj = 0; bj < 2; ++bj)
#pragma unroll
                    for (int n = 0; n < 2; ++n) { const f32x4 x = v[ai][bj][m][n]; s += (x[0] + x[1]) + (x[2] + x[3]); }
                s += __shfl_xor(s, 16); s += __shfl_xor(s, 32);
                const float mw = s * (1.0f / 64.0f); float q = 0.f;
#pragma unroll
                for (int bj = 0; bj < 2; ++bj)
#pragma unroll
                    for (int n = 0; n < 2; ++n) { const f32x4 d = v[ai][bj][m][n] - mw; q += (d[0] * d[0] + d[1] * d[1]) + (d[2] * d[2] + d[3] * d[3]); }
                q += __shfl_xor(q, 16); q += __shfl_xor(q, 32);
                if (fq == 0) P[(ai * HALF + wr * 64 + m * 16 + fr) * 4 + wc] = (f32x2v){mw, q};
            }
        asm volatile("s_waitcnt lgkmcnt(0)" ::: "memory"); __builtin_amdgcn_s_barrier(); asm volatile("" ::: "memory");
#if defined(BROKEN_EXCHANGE_NO_WAIT)
#warning BROKEN CONTROL BUILD: the row-statistics exchange does not wait; results are wrong by design
        if (blockIdx.x >= 64) { const long long t0_ = clock64(); while (clock64() - t0_ < 60000) __builtin_amdgcn_s_sleep(8); }
#endif
        const int row = wid * 32 + (lane & 31);
        if (lane < 32) {
            const f32x2v a = P[row * 4 + 0], b = P[row * 4 + 1], c = P[row * 4 + 2], d = P[row * 4 + 3];
            const float mt = (a.x + b.x + c.x + d.x) * 0.25f;
            const float da = a.x - mt, db = b.x - mt, dc = c.x - mt, dd = d.x - mt;
            const float m2 = (a.y + b.y) + (c.y + d.y) + 64.0f * ((da * da + db * db) + (dc * dc + dd * dd));
            unsigned long long* slot = (unsigned long long*)xbuf + ((size_t)(u.pm * BM + row) * 4 + u.pn);
            __hip_atomic_store(slot, ((unsigned long long)__float_as_uint(m2) << 32) | __float_as_uint(mt), __ATOMIC_RELAXED, __HIP_MEMORY_SCOPE_AGENT);
        }
        asm volatile("s_waitcnt vmcnt(0)" ::: "memory");
        if (lane == 0) __hip_atomic_fetch_add(cnt + 64 * u.pm, 1u, __ATOMIC_RELAXED, __HIP_MEMORY_SCOPE_AGENT);
        if (wid == 0) {
            bool dead = false; const unsigned long long t0 = __builtin_amdgcn_s_memrealtime(); const unsigned want = 8u * (unsigned)ntn;
            for (;;) {
#if defined(BROKEN_EXCHANGE_NO_WAIT)
                break;
#endif
                if ((unsigned)__builtin_amdgcn_readfirstlane(__hip_atomic_load(cnt + 64 * u.pm, __ATOMIC_RELAXED, __HIP_MEMORY_SCOPE_AGENT)) >= want) break;
                if (__builtin_amdgcn_s_memrealtime() - t0 > 2000000ull) {
                    if (lane == 0) { unsigned expect = 0u; __hip_atomic_compare_exchange_strong(tmo + 1, &expect, code | (unsigned)(u.pm & 0xff), __ATOMIC_RELAXED, __ATOMIC_RELAXED, __HIP_MEMORY_SCOPE_AGENT);
                                     __hip_atomic_store(tmo, 1u, __ATOMIC_RELAXED, __HIP_MEMORY_SCOPE_AGENT); }
                    dead = true; break; }
                __builtin_amdgcn_s_sleep(2);
            }
            __builtin_amdgcn_fence(__ATOMIC_ACQUIRE, "agent");
            if (lane == 0) flag[0] = dead ? 1u : 0u;
        }
        asm volatile("s_waitcnt vmcnt(0) lgkmcnt(0)" ::: "memory"); __builtin_amdgcn_s_barrier(); asm volatile("" ::: "memory");
        const bool bad = flag[0] != 0u;
        if (lane < 32) {
            const unsigned long long* slot = (const unsigned long long*)xbuf + (size_t)(u.pm * BM + row) * 4; float mt[4], m2[4]; float ms = 0.f;
#pragma unroll
            for (int t = 0; t < 4; ++t) { if (t < ntn) { const unsigned long long w = __hip_atomic_load(slot + t, __ATOMIC_RELAXED, __HIP_MEMORY_SCOPE_AGENT); mt[t] = __uint_as_float((unsigned)w); m2[t] = __uint_as_float((unsigned)(w >> 32)); } else { mt[t] = 0.f; m2[t] = 0.f; } ms += mt[t]; }
            const float mean = ms / (float)ntn; float q = 0.f;
#pragma unroll
            for (int t = 0; t < 4; ++t) if (t < ntn) { const float dm = mt[t] - mean; q += m2[t] + 256.0f * dm * dm; }
            S[row] = (f32x2v){mean, 1.0f / sqrtf(q / (256.0f * (float)ntn) + eps)};
        }
        asm volatile("s_waitcnt lgkmcnt(0)" ::: "memory"); __builtin_amdgcn_s_barrier(); asm volatile("" ::: "memory");
        return bad;
    }
};
struct EpiLnRes {
    static constexpr bool PERM = false, AFTER_DRAIN = true;
    const float* base; float* out; int ldc; const float* bias; PanelStats st; unsigned poison;
    __device__ __forceinline__ void fused(f32x4 (&acc)[2][2][4][2], const Unit& u, int wr, int wc, int fr, int fq, PG8_LAS unsigned char* lds, int wid, int lane) const {
        typedef float f32x2v __attribute__((ext_vector_type(2)));
        const PG8_LAS f32x2v* S = (const PG8_LAS f32x2v*)(lds + 8192);
        const int col0 = u.pn * BM + wc * 32 + 4 * fq;
#pragma unroll
        for (int bj = 0; bj < 2; ++bj)
#pragma unroll
            for (int n = 0; n < 2; ++n) { const f32x4 bv = bias ? *(const f32x4*)(bias + col0 + bj * HALF + n * 16) : (f32x4){0.f, 0.f, 0.f, 0.f};
#pragma unroll
                for (int ai = 0; ai < 2; ++ai)
#pragma unroll
                    for (int m = 0; m < 4; ++m) acc[ai][bj][m][n] += bv; }
        f32x4 pre[4][2][2];
#pragma unroll
        for (int m = 0; m < 4; ++m) { const size_t off = (size_t)(u.pm * BM + wr * 64 + m * 16 + fr) * ldc + col0;
#pragma unroll
            for (int bj = 0; bj < 2; ++bj)
#pragma unroll
                for (int n = 0; n < 2; ++n) pre[m][bj][n] = *(const f32x4*)(base + off + bj * HALF + n * 16); }
        const bool bad = st.run(acc, u, wr, wc, fr, fq, lds, wid, lane) || poison != 0u;
        const float qnan = __builtin_nanf("");
#pragma unroll
        for (int ai = 0; ai < 2; ++ai)
#pragma unroll
            for (int m = 0; m < 4; ++m) { const int r = ai * HALF + wr * 64 + m * 16 + fr; const f32x2v sr = S[r]; const size_t off = (size_t)(u.pm * BM + r) * ldc + col0;
#pragma unroll
                for (int bj = 0; bj < 2; ++bj)
#pragma unroll
                    for (int n = 0; n < 2; ++n) { const f32x4 bs = ai == 0 ? pre[m][bj][n] : *(const f32x4*)(base + off + bj * HALF + n * 16); f32x4 o = bs + (acc[ai][bj][m][n] - sr.x) * sr.y;
                        if (bad) o = (f32x4){qnan, qnan, qnan, qnan}; *(f32x4*)(out + off + bj * HALF + n * 16) = o; }
                if (m & 1) asm volatile("" ::: "memory"); }
    }
};
struct EpiLnResLn {
    static constexpr bool PERM = false, AFTER_DRAIN = true;
    const float* base; float* out; bf16_t* xn; int ldc; const float* bias; PanelStats st1, st2; unsigned poison;
    __device__ __forceinline__ void fused(f32x4 (&acc)[2][2][4][2], const Unit& u, int wr, int wc, int fr, int fq, PG8_LAS unsigned char* lds, int wid, int lane) const {
        typedef float f32x2v __attribute__((ext_vector_type(2))); typedef unsigned u32x2v __attribute__((ext_vector_type(2)));
        const PG8_LAS f32x2v* S = (const PG8_LAS f32x2v*)(lds + 8192);
        const int col0 = u.pn * BM + wc * 32 + 4 * fq;
#pragma unroll
        for (int bj = 0; bj < 2; ++bj)
#pragma unroll
            for (int n = 0; n < 2; ++n) { const f32x4 bv = bias ? *(const f32x4*)(bias + col0 + bj * HALF + n * 16) : (f32x4){0.f, 0.f, 0.f, 0.f};
#pragma unroll
                for (int ai = 0; ai < 2; ++ai)
#pragma unroll
                    for (int m = 0; m < 4; ++m) acc[ai][bj][m][n] += bv; }
        bool bad = st1.run(acc, u, wr, wc, fr, fq, lds, wid, lane) || poison != 0u;
        const float qnan = __builtin_nanf("");
#pragma unroll
        for (int ai = 0; ai < 2; ++ai)
#pragma unroll
            for (int m = 0; m < 4; ++m) { const int r = ai * HALF + wr * 64 + m * 16 + fr; const f32x2v sr = S[r]; const size_t off = (size_t)(u.pm * BM + r) * ldc + col0;
#pragma unroll
                for (int bj = 0; bj < 2; ++bj)
#pragma unroll
                    for (int n = 0; n < 2; ++n) { const f32x4 bs = *(const f32x4*)(base + off + bj * HALF + n * 16); acc[ai][bj][m][n] = bs + (acc[ai][bj][m][n] - sr.x) * sr.y; }
                asm volatile("" : "+v"(acc[ai][0][m][0]), "+v"(acc[ai][0][m][1]), "+v"(acc[ai][1][m][0]), "+v"(acc[ai][1][m][1]));
                if (m & 1) asm volatile("" ::: "memory"); }
        const bool bad1 = bad;
        bad = st2.run(acc, u, wr, wc, fr, fq, lds, wid, lane) || bad;
#pragma unroll
        for (int ai = 0; ai < 2; ++ai)
#pragma unroll
            for (int m = 0; m < 4; ++m) { const int r = ai * HALF + wr * 64 + m * 16 + fr; const f32x2v sr = S[r]; const size_t off = (size_t)(u.pm * BM + r) * ldc + col0;
#pragma unroll
                for (int bj = 0; bj < 2; ++bj)
#pragma unroll
                    for (int n = 0; n < 2; ++n) { const f32x4 x1 = acc[ai][bj][m][n]; *(f32x4*)(out + off + bj * HALF + n * 16) = bad1 ? (f32x4){qnan, qnan, qnan, qnan} : x1;
                        const f32x4 o = (x1 - sr.x) * sr.y; u32x2v w; w.x = cvt_pk_bf16(o[0], o[1]); w.y = cvt_pk_bf16(o[2], o[3]);
                        if (bad) { w.x = 0x7fc07fc0u; w.y = 0x7fc07fc0u; } *(u32x2v*)(xn + off + bj * HALF + n * 16) = w; }
                asm volatile("" ::: "memory"); }
    }
};

template <class Epi, class Sched, bool ALIGN_EPI = false, bool SP2 = false>
__device__ __forceinline__ void gemm_phase(PG8_LAS unsigned char* lds, const Gemm g, const Sched& S, const Epi& E) {
    const int tid = threadIdx.x, wid = __builtin_amdgcn_readfirstlane(tid >> 6), lane = tid & 63, wr = wid >> 2, wc = wid & 3, fr = lane & 15, fq = lane >> 4;
    const int K = g.ld ? g.ld : g.K, nt = g.K / BK;
    unsigned voffA[2], voffB[2];
#pragma unroll
    for (int i = 0; i < 2; ++i) { int R, C; stage_rc(tid * 16 + i * 8192, R, C); const int Rb = Epi::PERM ? ((R & ~31) + perm32(R & 31)) : R;
        voffA[i] = (unsigned)(R * K + C) * 2u; voffB[i] = (unsigned)(Rb * K + C) * 2u; }
    const size_t kstep = (size_t)(BK * 2);
    const size_t hstep = (size_t)HALF * K * 2;
    const size_t tstep = 2 * hstep;
    const unsigned ldsw = (unsigned)wid * 1024u;
    const int aoff = lds_byte(wr * 64 + fr, fq * 8), boff = lds_byte(wc * 32 + fr, fq * 8);
#define PG8_SA(b, h) (((b) * 2 + (h)) * HTB)
#define PG8_SB(b, h) ((4 + (b) * 2 + (h)) * HTB)
#define PG8_STAGE(bufoff, gbase, voff) do { _Pragma("unroll") for (int _i = 0; _i < 2; ++_i) \
        __builtin_amdgcn_global_load_lds((const unsigned*)((const char*)(gbase) + (voff)[_i]), (PG8_LAS unsigned*)(lds + (bufoff) + ldsw + _i * 8192), 16, 0, 0); } while (0)
#define PG8_LDA(dst, b, h) do { _Pragma("unroll") for (int m = 0; m < 4; ++m) _Pragma("unroll") for (int k = 0; k < 2; ++k) dst[m][k] = *(const PG8_LAS bf16x8*)(lds + PG8_SA(b, h) + aoff + m * 2048 + k * 1024); } while (0)
#define PG8_LDB(dst, b, h) do { _Pragma("unroll") for (int n = 0; n < 2; ++n) _Pragma("unroll") for (int k = 0; k < 2; ++k) dst[n][k] = *(const PG8_LAS bf16x8*)(lds + PG8_SB(b, h) + boff + n * 2048 + k * 1024); } while (0)
#define PG8_MMA(ai, bj, At, Bt) do { __builtin_amdgcn_s_setprio(1); _Pragma("unroll") for (int m = 0; m < 4; ++m) _Pragma("unroll") for (int n = 0; n < 2; ++n) _Pragma("unroll") for (int k = 0; k < 2; ++k) \
        acc[ai][bj][m][n] = __builtin_amdgcn_mfma_f32_16x16x32_bf16(Bt[n][k], At[m][k], acc[ai][bj][m][n], 0, 0, 0); __builtin_amdgcn_s_setprio(0); } while (0)
#define PG8_WAIT_V(n) asm volatile("s_waitcnt vmcnt(" #n ")" ::: "memory")
#define PG8_WAIT_L(n) asm volatile("s_waitcnt lgkmcnt(" #n ")" ::: "memory")
#define PG8_BAR __builtin_amdgcn_s_barrier()
#define PG8_SCHED __builtin_amdgcn_sched_barrier(0)
    Unit cur, nxt; int ui = 0;
    if (!S.next(0, cur)) return;
    f32x4 acc[2][2][4][2];
#pragma unroll
    for (int a = 0; a < 2; ++a)
#pragma unroll
        for (int b = 0; b < 2; ++b)
#pragma unroll
            for (int m = 0; m < 4; ++m)
#pragma unroll
                for (int n = 0; n < 2; ++n) acc[a][b][m][n] = (f32x4){0.f, 0.f, 0.f, 0.f};
    bf16x8 At[4][2], B0[2][2], B1[2][2];
    const char* cA = (const char*)g.A + (size_t)cur.pm * tstep + (size_t)cur.k0 * 2; const char* cB = (const char*)g.Bt + (size_t)cur.pn * tstep + (size_t)cur.k0 * 2;
    S.a_ready(cur);
    if constexpr (SP2) {
        PG8_STAGE(PG8_SB(0, 0), cB, voffB); PG8_STAGE(PG8_SB(0, 1), cB + hstep, voffB); PG8_STAGE(PG8_SA(0, 0), cA, voffA); PG8_STAGE(PG8_SA(0, 1), cA + hstep, voffA);
        if (wr == 1) PG8_BAR;
        PG8_WAIT_V(2); PG8_BAR;
        PG8_STAGE(PG8_SB(1, 0), cB + kstep, voffB); PG8_STAGE(PG8_SA(1, 0), cA + kstep, voffA); PG8_STAGE(PG8_SB(1, 1), cB + hstep + kstep, voffB);
        PG8_WAIT_V(6); PG8_BAR;
    } else {
        PG8_STAGE(PG8_SB(0, 0), cB, voffB); PG8_STAGE(PG8_SA(0, 0), cA, voffA); PG8_STAGE(PG8_SB(0, 1), cB + hstep, voffB); PG8_STAGE(PG8_SA(0, 1), cA + hstep, voffA);
        if (wr == 1) PG8_BAR;
        PG8_WAIT_V(4); PG8_BAR;
        PG8_STAGE(PG8_SB(1, 0), cB + kstep, voffB); PG8_STAGE(PG8_SA(1, 0), cA + kstep, voffA); PG8_STAGE(PG8_SB(1, 1), cB + hstep + kstep, voffB);
        PG8_WAIT_V(6); PG8_BAR;
    }
    for (;;) {
        const bool has_next = S.next(ui + 1, nxt);
        const char* nA = has_next ? (const char*)g.A + (size_t)nxt.pm * tstep + (size_t)nxt.k0 * 2 : cA; const char* nB = has_next ? (const char*)g.Bt + (size_t)nxt.pn * tstep + (size_t)nxt.k0 * 2 : cB;
        for (int t = 0; t < nt; t += 2) {
            const bool last = (t == nt - 2);
            const char* a1 = cA + (size_t)(t + 1) * kstep;
            const char* a2 = last ? nA : cA + (size_t)(t + 2) * kstep; const char* b2 = last ? nB : cB + (size_t)(t + 2) * kstep;
            const char* a3 = a2 + kstep; const char* b3 = b2 + kstep;
            if (last && has_next) S.a_ready(nxt);
            if constexpr (SP2) {
            PG8_LDB(B0, 0, 0); PG8_LDB(B1, 0, 1); PG8_SCHED; PG8_LDA(At, 0, 0); PG8_STAGE(PG8_SA(1, 1), a1 + hstep, voffA);
            PG8_WAIT_V(8); PG8_WAIT_L(0); PG8_BAR; PG8_MMA(0, 0, At, B0); PG8_MMA(0, 1, At, B1); PG8_BAR; PG8_SCHED;
            PG8_LDA(At, 0, 1); PG8_STAGE(PG8_SB(0, 0), b2, voffB); PG8_STAGE(PG8_SB(0, 1), b2 + hstep, voffB); PG8_STAGE(PG8_SA(0, 0), a2, voffA);
            PG8_WAIT_V(8); PG8_WAIT_L(0); PG8_BAR; PG8_MMA(1, 0, At, B0); PG8_MMA(1, 1, At, B1); PG8_BAR; PG8_SCHED;
            PG8_LDB(B0, 1, 0); PG8_LDB(B1, 1, 1); PG8_SCHED; PG8_LDA(At, 1, 0); PG8_STAGE(PG8_SA(0, 1), a2 + hstep, voffA);
            PG8_WAIT_V(8); PG8_WAIT_L(0); PG8_BAR; PG8_MMA(0, 0, At, B0); PG8_MMA(0, 1, At, B1); PG8_BAR; PG8_SCHED;
            PG8_LDA(At, 1, 1); PG8_STAGE(PG8_SB(1, 0), b3, voffB); PG8_STAGE(PG8_SB(1, 1), b3 + hstep, voffB); PG8_STAGE(PG8_SA(1, 0), a3, voffA);
            PG8_WAIT_V(8); PG8_WAIT_L(0); PG8_BAR; PG8_MMA(1, 0, At, B0); PG8_MMA(1, 1, At, B1); PG8_BAR; PG8_SCHED;
            } else {
            PG8_LDB(B0, 0, 0); PG8_SCHED; PG8_LDA(At, 0, 0); PG8_STAGE(PG8_SA(1, 1), a1 + hstep, voffA);
            PG8_WAIT_L(8); PG8_BAR; PG8_WAIT_L(0); PG8_MMA(0, 0, At, B0); PG8_BAR; PG8_SCHED;
            PG8_LDB(B1, 0, 1); PG8_STAGE(PG8_SB(0, 0), b2, voffB);
            PG8_BAR; PG8_WAIT_L(0); PG8_MMA(0, 1, At, B1); PG8_BAR;
            PG8_LDA(At, 0, 1); PG8_STAGE(PG8_SA(0, 0), a2, voffA);
            PG8_BAR; PG8_WAIT_L(0); PG8_MMA(1, 0, At, B0); PG8_BAR; PG8_SCHED;
            PG8_STAGE(PG8_SB(0, 1), b2 + hstep, voffB);
            PG8_WAIT_V(6); PG8_BAR; PG8_MMA(1, 1, At, B1); PG8_BAR;
            PG8_LDB(B0, 1, 0); PG8_SCHED; PG8_LDA(At, 1, 0); PG8_STAGE(PG8_SA(0, 1), a2 + hstep, voffA);
            PG8_WAIT_L(8); PG8_BAR; PG8_WAIT_L(0); PG8_MMA(0, 0, At, B0); PG8_BAR; PG8_SCHED;
            PG8_LDB(B1, 1, 1); PG8_STAGE(PG8_SB(1, 0), b3, voffB);
            PG8_BAR; PG8_WAIT_L(0); PG8_MMA(0, 1, At, B1); PG8_BAR;
            PG8_LDA(At, 1, 1); PG8_STAGE(PG8_SA(1, 0), a3, voffA);
            PG8_BAR; PG8_WAIT_L(0); PG8_MMA(1, 0, At, B0); PG8_BAR; PG8_SCHED;
            PG8_STAGE(PG8_SB(1, 1), b3 + hstep, voffB);
            PG8_WAIT_V(6); PG8_BAR; PG8_MMA(1, 1, At, B1); PG8_BAR;
            }
        }
        if constexpr (ALIGN_EPI) { if (wr == 0) PG8_BAR; }
        if constexpr (!Epi::AFTER_DRAIN) { E(acc, cur, wr, wc, fr, fq); S.done(cur); }
        if (!has_next) break;
#pragma unroll
        for (int a = 0; a < 2; ++a)
#pragma unroll
            for (int b = 0; b < 2; ++b)
#pragma unroll
                for (int m = 0; m < 4; ++m)
#pragma unroll
                    for (int n = 0; n < 2; ++n) acc[a][b][m][n] = (f32x4){0.f, 0.f, 0.f, 0.f};
        cur = nxt; cA = nA; cB = nB; ++ui;
        if constexpr (ALIGN_EPI) { if (wr == 1) PG8_BAR; }
    }
    PG8_WAIT_V(0);
    if constexpr (!ALIGN_EPI) { if (wr == 0) PG8_BAR; }
    PG8_BAR;
    if constexpr (Epi::AFTER_DRAIN) { E.fused(acc, cur, wr, wc, fr, fq, lds, wid, lane); S.done(cur); }
#undef PG8_SA
#undef PG8_SB
#undef PG8_STAGE
#undef PG8_LDA
#undef PG8_LDB
#undef PG8_MMA
#undef PG8_WAIT_V
#undef PG8_WAIT_L
#undef PG8_BAR
#undef PG8_SCHED
}
}


__device__ __forceinline__ float xl_dpp_b1(float x) { return __uint_as_float((unsigned)__builtin_amdgcn_update_dpp(0, (int)__float_as_uint(x), 0xB1, 0xF, 0xF, true)); }
__device__ __forceinline__ float xl_dpp_4e(float x) { return __uint_as_float((unsigned)__builtin_amdgcn_update_dpp(0, (int)__float_as_uint(x), 0x4E, 0xF, 0xF, true)); }
__device__ __forceinline__ float xl_mir8(float x)   { return __uint_as_float((unsigned)__builtin_amdgcn_update_dpp(0, (int)__float_as_uint(x), 0x141, 0xF, 0xF, true)); }
__device__ __forceinline__ float xl_mir16(float x)  { return __uint_as_float((unsigned)__builtin_amdgcn_update_dpp(0, (int)__float_as_uint(x), 0x140, 0xF, 0xF, true)); }
__device__ __forceinline__ float xl_xor16(float x) { const auto rr = __builtin_amdgcn_permlane16_swap(__float_as_uint(x), __float_as_uint(x), false, false); return __uint_as_float((threadIdx.x & 16) ? rr[0] : rr[1]); }
__device__ __forceinline__ float xl_xor32(float x) { const auto rr = __builtin_amdgcn_permlane32_swap(__float_as_uint(x), __float_as_uint(x), false, false); return __uint_as_float((threadIdx.x & 32) ? rr[0] : rr[1]); }
namespace pg8 {
typedef unsigned u32x2 __attribute__((ext_vector_type(2)));
__device__ __forceinline__ float bflo(unsigned w) { return __uint_as_float(w << 16); }
__device__ __forceinline__ float bfhi(unsigned w) { return __uint_as_float(w & 0xffff0000u); }
__device__ __forceinline__ float silu_f(float x) { return x * __builtin_amdgcn_rcpf(1.0f + __expf(-x)); }
__device__ __forceinline__ float sigm_f(float x) { return __builtin_amdgcn_rcpf(1.0f + __expf(-x)); }

struct EpiSwiglu {
    static constexpr bool PERM = true, AFTER_DRAIN = false;
    bf16_t* O; int ldc; const float* rs;
    __device__ __forceinline__ void operator()(const f32x4 (&acc)[2][2][4][2], const Unit& u, int wr, int wc, int fr, int fq) const {
        const int row0 = u.pm * BM + wr * 64 + fr, col0 = u.pn * HALF + wc * 32 + 8 * fq;
        const __amdgpu_buffer_rsrc_t rsrc = __builtin_amdgcn_make_buffer_rsrc(O, 0, 33280 * 2816 * 2, 0x00020000);
        float rsv[2][4];
#pragma unroll
        for (int ai = 0; ai < 2; ++ai)
#pragma unroll
            for (int m = 0; m < 4; ++m) rsv[ai][m] = rs[row0 + ai * HALF + m * 16];
#pragma unroll
        for (int ai = 0; ai < 2; ++ai)
#pragma unroll
            for (int m = 0; m < 4; ++m) {
                const unsigned boff = (unsigned)(((row0 + ai * HALF + m * 16) * ldc + col0) * 2);
                const float rr = rsv[ai][m];
                const f32x4 g0 = acc[ai][0][m][0] * rr, g1 = acc[ai][0][m][1] * rr, u0 = acc[ai][1][m][0] * rr, u1 = acc[ai][1][m][1] * rr;
                u32x4 w;
                w.x = cvt_pk_bf16(silu_f(g0[0]) * u0[0], silu_f(g0[1]) * u0[1]); w.y = cvt_pk_bf16(silu_f(g0[2]) * u0[2], silu_f(g0[3]) * u0[3]);
                w.z = cvt_pk_bf16(silu_f(g1[0]) * u1[0], silu_f(g1[1]) * u1[1]); w.w = cvt_pk_bf16(silu_f(g1[2]) * u1[2], silu_f(g1[3]) * u1[3]);
                __builtin_amdgcn_raw_buffer_store_b128(w, rsrc, boff, 0, 16);
            }
    }
};
struct EpiPlain {
    static constexpr bool PERM = true, AFTER_DRAIN = false;
    bf16_t* O; int ldc; const float* rs;
    __device__ __forceinline__ void operator()(const f32x4 (&acc)[2][2][4][2], const Unit& u, int wr, int wc, int fr, int fq) const {
        const int row0 = u.pm * BM + wr * 64 + fr, col0 = u.pn * BM + wc * 32 + 8 * fq;
        float rsv[2][4];
#pragma unroll
        for (int ai = 0; ai < 2; ++ai)
#pragma unroll
            for (int m = 0; m < 4; ++m) rsv[ai][m] = rs[row0 + ai * HALF + m * 16];
#pragma unroll
        for (int ai = 0; ai < 2; ++ai)
#pragma unroll
            for (int m = 0; m < 4; ++m) {
                bf16_t* rowp = O + (size_t)(row0 + ai * HALF + m * 16) * ldc + col0;
                const float rr = rsv[ai][m];
#pragma unroll
                for (int bj = 0; bj < 2; ++bj) { const f32x4 v0 = acc[ai][bj][m][0] * rr, v1 = acc[ai][bj][m][1] * rr; u32x4 w;
                    w.x = cvt_pk_bf16(v0[0], v0[1]); w.y = cvt_pk_bf16(v0[2], v0[3]); w.z = cvt_pk_bf16(v1[0], v1[1]); w.w = cvt_pk_bf16(v1[2], v1[3]);
                    *(u32x4*)(rowp + bj * HALF) = w; }
            }
    }
};
struct EpiWin {
    static constexpr bool PERM = true, AFTER_DRAIN = false;
    bf16_t* Z; const float2* rope; const float* rs; PG8_LAS unsigned char* spare;
    __device__ __forceinline__ void operator()(const f32x4 (&acc)[2][2][4][2], const Unit& u, int wr, int wc, int fr, int fq) const {
        const int row0 = u.pm * BM + wr * 64 + fr, col0 = u.pn * BM + wc * 32 + 8 * fq;
        const bool ropetile = u.pn >= 2;
        PG8_LAS f32x2* RT = (PG8_LAS f32x2*)spare;
        const f32x2* rope2 = (const f32x2*)rope;
        float rsv[2][4];
#pragma unroll
        for (int ai = 0; ai < 2; ++ai)
#pragma unroll
            for (int m = 0; m < 4; ++m) rsv[ai][m] = rs[row0 + ai * HALF + m * 16];
#pragma unroll
        for (int ai = 0; ai < 2; ++ai) {
            if (ropetile) {
                if (ai) __builtin_amdgcn_s_barrier();
#pragma unroll
                for (int k = 0; k < 2; ++k) { const int idx = (int)threadIdx.x + 512 * k, row = u.pm * BM + ai * HALF + (idx >> 3);
                    const int pidx = row < 32768 ? (row & 8191) : 8192 + ((row - 32768) & 3); RT[idx] = rope2[pidx * 8 + (idx & 7)]; }
                asm volatile("s_waitcnt vmcnt(0) lgkmcnt(0)" ::: "memory"); __builtin_amdgcn_s_barrier(); asm volatile("" ::: "memory");
            }
#pragma unroll
            for (int m = 0; m < 4; ++m) {
                const int row = row0 + ai * HALF + m * 16;
                bf16_t* rowp = Z + (size_t)row * 1280 + col0;
                const float rr = rsv[ai][m];
#pragma unroll
                for (int bj = 0; bj < 2; ++bj) {
                    f32x4 v[2] = {acc[ai][bj][m][0] * rr, acc[ai][bj][m][1] * rr};
                    const bool dorope = ((u.pn == 2) || (u.pn == 3) || (u.pn == 4 && bj == 0)) && ((wc & 1) == 0);
                    if (dorope) {
#pragma unroll
                        for (int n = 0; n < 2; ++n)
#pragma unroll
                            for (int e = 0; e < 4; ++e) {
                                const float x = v[n][e]; const float p = xl_xor16(x);
                                const f32x2 cs = RT[(wr * 64 + m * 16 + fr) * 8 + 4 * n + e];
                                const float r0 = x * cs.x - p * cs.y, r1 = x * cs.x + p * cs.y;
                                v[n][e] = fq == 0 ? r0 : (fq == 1 ? r1 : x);
                            }
                    }
                    u32x4 w; w.x = cvt_pk_bf16(v[0][0], v[0][1]); w.y = cvt_pk_bf16(v[0][2], v[0][3]); w.z = cvt_pk_bf16(v[1][0], v[1][1]); w.w = cvt_pk_bf16(v[1][2], v[1][3]);
                    *(u32x4*)(rowp + bj * HALF) = w;
                }
            }
        }
    }
};
struct EpiGlu {
    static constexpr bool PERM = true, AFTER_DRAIN = false;
    const bf16_t* G; const float* bias; bf16_t* O; int ldo; unsigned* cnt;
    __device__ __forceinline__ void operator()(const f32x4 (&acc)[2][2][4][2], const Unit& u, int wr, int wc, int fr, int fq) const {
        const int row0 = u.pm * BM + wr * 64 + fr, col0 = u.pn * BM + wc * 32 + 8 * fq;
        const __amdgpu_buffer_rsrc_t rsrc = __builtin_amdgcn_make_buffer_rsrc(O, 0, 33280 * 1024 * 2, 0x00020000);
#pragma unroll
        for (int ai = 0; ai < 2; ++ai)
#pragma unroll
            for (int m = 0; m < 4; ++m) {
                const int row = row0 + ai * HALF + m * 16;
#pragma unroll
                for (int bj = 0; bj < 2; ++bj) {
                    const int col = col0 + bj * HALF;
                    const u32x4 gv = *(const u32x4*)(G + (size_t)row * 512 + col);
                    const f32x4 b0 = *(const f32x4*)(bias + col), b1 = *(const f32x4*)(bias + col + 4);
                    const f32x4 v0 = acc[ai][bj][m][0] + b0, v1 = acc[ai][bj][m][1] + b1;
                    u32x4 w;
                    w.x = cvt_pk_bf16(bflo(gv.x) * sigm_f(v0[0]), bfhi(gv.x) * sigm_f(v0[1])); w.y = cvt_pk_bf16(bflo(gv.y) * sigm_f(v0[2]), bfhi(gv.y) * sigm_f(v0[3]));
                    w.z = cvt_pk_bf16(bflo(gv.z) * sigm_f(v1[0]), bfhi(gv.z) * sigm_f(v1[1])); w.w = cvt_pk_bf16(bflo(gv.w) * sigm_f(v1[2]), bfhi(gv.w) * sigm_f(v1[3]));
                    __builtin_amdgcn_raw_buffer_store_b128(w, rsrc, (unsigned)((row * ldo + col) * 2), 0, 16);
                }
            }
        asm volatile("s_waitcnt vmcnt(0)" ::: "memory");
        __builtin_amdgcn_s_barrier();
        if (threadIdx.x == 0) __hip_atomic_fetch_add(cnt + 64 * u.pm, 1u, __ATOMIC_RELAXED, __HIP_MEMORY_SCOPE_AGENT);
    }
};
struct PanelOrder2 {
    int vc;
    __device__ bool next(int i, Unit& u) const { if (i > 0) return false; u.pm = vc >> 1; u.pn = vc & 1; u.k0 = 0; return true; }
    __device__ __forceinline__ void a_ready(const Unit&) const {}
    __device__ __forceinline__ void done(const Unit&) const {}
};
struct EpiMemKV {
    static constexpr bool PERM = true, AFTER_DRAIN = false;
    float* OKp; float* OVp; bf16_t* MK; bf16_t* MVT;
    __device__ __forceinline__ void operator()(const f32x4 (&acc)[2][2][4][2], const Unit& u, int wr, int wc, int fr, int fq) const {
        const int row0 = u.pm * BM + wr * 64 + fr, col0 = u.pn * BM + wc * 32 + 8 * fq;
#pragma unroll
        for (int ai = 0; ai < 2; ++ai)
#pragma unroll
            for (int m = 0; m < 4; ++m) {
                const int row = row0 + ai * HALF + m * 16;
#pragma unroll
                for (int bj = 0; bj < 2; ++bj) {
                    const int col = col0 + bj * HALF;
                    const f32x4 v0 = acc[ai][bj][m][0], v1 = acc[ai][bj][m][1];
                    if (u.pn < 4) {
                        *(f32x4*)(OKp + (size_t)row * 1024 + col) = v0; *(f32x4*)(OKp + (size_t)row * 1024 + col + 4) = v1;
                        u32x4 w; w.x = cvt_pk_bf16(v0[0], v0[1]); w.y = cvt_pk_bf16(v0[2], v0[3]); w.z = cvt_pk_bf16(v1[0], v1[1]); w.w = cvt_pk_bf16(v1[2], v1[3]);
                        *(u32x4*)(MK + (size_t)row * 1024 + col) = w;
                    } else {
                        const int cv = col - 1024;
                        *(f32x4*)(OVp + (size_t)row * 1024 + cv) = v0; *(f32x4*)(OVp + (size_t)row * 1024 + cv + 4) = v1;
                        const int b = row >> 8, mt = row & 255;
                        bf16_t* vt = MVT + ((size_t)(b * 1024 + cv) * 256 + mt);
                        const unsigned w0 = cvt_pk_bf16(v0[0], v0[1]), w1 = cvt_pk_bf16(v0[2], v0[3]), w2 = cvt_pk_bf16(v1[0], v1[1]), w3 = cvt_pk_bf16(v1[2], v1[3]);
                        vt[0 * 256] = (bf16_t)w0; vt[1 * 256] = (bf16_t)(w0 >> 16); vt[2 * 256] = (bf16_t)w1; vt[3 * 256] = (bf16_t)(w1 >> 16);
                        vt[4 * 256] = (bf16_t)w2; vt[5 * 256] = (bf16_t)(w2 >> 16); vt[6 * 256] = (bf16_t)w3; vt[7 * 256] = (bf16_t)(w3 >> 16);
                    }
                }
            }
    }
};

struct EpiPlainCnt {
    static constexpr bool PERM = true, AFTER_DRAIN = false;
    bf16_t* O; int ldc; unsigned* cntA; unsigned* cntB;
    __device__ __forceinline__ void operator()(const f32x4 (&acc)[2][2][4][2], const Unit& u, int wr, int wc, int fr, int fq) const {
        const int row0 = u.pm * BM + wr * 64 + fr, col0 = u.pn * BM + wc * 32 + 8 * fq;
        const __amdgpu_buffer_rsrc_t rsrc = __builtin_amdgcn_make_buffer_rsrc(O, 0, 33280 * 1024 * 2, 0x00020000);
#pragma unroll
        for (int ai = 0; ai < 2; ++ai)
#pragma unroll
            for (int m = 0; m < 4; ++m) {
                const unsigned boff = (unsigned)(((row0 + ai * HALF + m * 16) * ldc + col0) * 2);
#pragma unroll
                for (int bj = 0; bj < 2; ++bj) { const f32x4 v0 = acc[ai][bj][m][0], v1 = acc[ai][bj][m][1]; u32x4 w;
                    w.x = cvt_pk_bf16(v0[0], v0[1]); w.y = cvt_pk_bf16(v0[2], v0[3]); w.z = cvt_pk_bf16(v1[0], v1[1]); w.w = cvt_pk_bf16(v1[2], v1[3]);
                    __builtin_amdgcn_raw_buffer_store_b128(w, rsrc, boff + bj * HALF * 2, 0,   16); }
            }
        asm volatile("s_waitcnt vmcnt(0)" ::: "memory");
        __builtin_amdgcn_s_barrier();
        if (threadIdx.x == 0) __hip_atomic_fetch_add(cntA + 64 * u.pm, 1u, __ATOMIC_RELAXED, __HIP_MEMORY_SCOPE_AGENT);
    }
};
struct PanelOrder {
    int nwg, G, vc;
    __device__ void init(int M, int G_, int vc_) { nwg = (M / BM) * 4; G = G_; vc = vc_; }
    __device__ bool next(int i, Unit& u) const { const int L = i * G + vc; if (L >= nwg) return false; u.pm = L >> 2; u.pn = L & 3; u.k0 = 0; return true; }
    __device__ __forceinline__ void a_ready(const Unit&) const {}
    __device__ __forceinline__ void done(const Unit&) const {}
};
struct OneUnitOrder {
    int pm, pn;
    __device__ bool next(int i, Unit& u) const { if (i > 0) return false; u.pm = pm; u.pn = pn; u.k0 = 0; return true; }
    __device__ __forceinline__ void a_ready(const Unit&) const {}
    __device__ __forceinline__ void done(const Unit&) const {}
};
struct SampleSplitOrder {
    int vc, khalf;
    __device__ bool next(int i, Unit& u) const { if (i > 0 || vc >= 16) return false; u.pm = 128 + (vc >> 3); u.pn = (vc >> 1) & 3; u.k0 = (vc & 1) * khalf; return true; }
    __device__ __forceinline__ void a_ready(const Unit&) const {}
    __device__ __forceinline__ void done(const Unit&) const {}
};
struct SampleSplit4Order {
    int li, k0;
    __device__ bool next(int i, Unit& u) const { if (i > 0) return false; u.pm = 128 + (li >> 4); u.pn = (li >> 2) & 3; u.k0 = k0; return true; }
    __device__ __forceinline__ void a_ready(const Unit&) const {}
    __device__ __forceinline__ void done(const Unit&) const {}
};
struct EpiPart4F32 {
    static constexpr bool PERM = true, AFTER_DRAIN = false;
    float* CS; int part; unsigned* cnt;
    __device__ __forceinline__ void operator()(const f32x4 (&acc)[2][2][4][2], const Unit& u, int wr, int wc, int fr, int fq) const {
        const int row0 = (u.pm - 128) * BM + wr * 64 + fr, col0 = u.pn * BM + wc * 32 + 8 * fq;
        const __amdgpu_buffer_rsrc_t rsrc = __builtin_amdgcn_make_buffer_rsrc(CS, 0, 4 * 512 * 1024 * 4, 0x00020000);
        const unsigned hoff = (unsigned)part * 512u * 1024u * 4u;
#pragma unroll
        for (int ai = 0; ai < 2; ++ai)
#pragma unroll
            for (int m = 0; m < 4; ++m) {
                const unsigned boff = hoff + (unsigned)(((row0 + ai * HALF + m * 16) * 1024 + col0) * 4);
#pragma unroll
                for (int bj = 0; bj < 2; ++bj) { __builtin_amdgcn_raw_buffer_store_b128(__builtin_bit_cast(u32x4, acc[ai][bj][m][0]), rsrc, boff + bj * HALF * 4, 0, 16);
                    __builtin_amdgcn_raw_buffer_store_b128(__builtin_bit_cast(u32x4, acc[ai][bj][m][1]), rsrc, boff + bj * HALF * 4 + 16, 0, 16); }
            }
        asm volatile("s_waitcnt vmcnt(0)" ::: "memory");
        __builtin_amdgcn_s_barrier();
        if (threadIdx.x == 0) __hip_atomic_fetch_add(cnt, 1u, __ATOMIC_RELAXED, __HIP_MEMORY_SCOPE_AGENT);
    }
};
struct EpiPartF32 {
    static constexpr bool PERM = true, AFTER_DRAIN = false;
    float* CS; int khalf; unsigned* cnt;
    __device__ __forceinline__ void operator()(const f32x4 (&acc)[2][2][4][2], const Unit& u, int wr, int wc, int fr, int fq) const {
        const int row0 = (u.pm - 128) * BM + wr * 64 + fr, col0 = u.pn * BM + wc * 32 + 8 * fq;
        const __amdgpu_buffer_rsrc_t rsrc = __builtin_amdgcn_make_buffer_rsrc(CS, 0, 2 * 512 * 1024 * 4, 0x00020000);
        const unsigned hoff = (u.k0 ? 1u : 0u) * 512u * 1024u * 4u;
#pragma unroll
        for (int ai = 0; ai < 2; ++ai)
#pragma unroll
            for (int m = 0; m < 4; ++m) {
                const unsigned boff = hoff + (unsigned)(((row0 + ai * HALF + m * 16) * 1024 + col0) * 4);
#pragma unroll
                for (int bj = 0; bj < 2; ++bj) { __builtin_amdgcn_raw_buffer_store_b128(__builtin_bit_cast(u32x4, acc[ai][bj][m][0]), rsrc, boff + bj * HALF * 4, 0, 16);
                    __builtin_amdgcn_raw_buffer_store_b128(__builtin_bit_cast(u32x4, acc[ai][bj][m][1]), rsrc, boff + bj * HALF * 4 + 16, 0, 16); }
            }
        asm volatile("s_waitcnt vmcnt(0)" ::: "memory");
        __builtin_amdgcn_s_barrier();
        if (threadIdx.x == 0) __hip_atomic_fetch_add(cnt, 1u, __ATOMIC_RELAXED, __HIP_MEMORY_SCOPE_AGENT);
    }
};
}

#include <hip/hip_cooperative_groups.h>
namespace cg = cooperative_groups;

#define LAS __attribute__((address_space(3)))
typedef unsigned short bf16;
typedef unsigned v4u __attribute__((ext_vector_type(4)));
typedef unsigned v2u __attribute__((ext_vector_type(2)));
typedef float f32x4 __attribute__((ext_vector_type(4)));
typedef float f32x16 __attribute__((ext_vector_type(16)));
typedef short bf16x8 __attribute__((ext_vector_type(8)));
typedef short s16x4 __attribute__((ext_vector_type(4)));

constexpr int NWAVES = 8, NTHR = 512;
constexpr int D = 1024, FF = 2816, NPROW = 32768, NSROW = 512, M = NPROW + NSROW, SEQ = 8192, NB = 4, DB = 128, INW = 1280;
constexpr float EPS = 1e-6f;
constexpr size_t MiB = 1u << 20;
constexpr size_t WS_ROPE = 1 * MiB, WS_SSM = 2 * MiB, WS_MN = 3 * MiB;
constexpr size_t WS_W1GU = 5 * MiB, WS_W1D = 16 * MiB, WS_W2GU = 22 * MiB, WS_W2D = 33 * MiB, WS_WIN = 39 * MiB, WS_WGLU = 42 * MiB, WS_WOUT = 43 * MiB, WS_WMQ = 45 * MiB, WS_WMKV = 47 * MiB, WS_WMO = 51 * MiB;
constexpr size_t WS_XN = 56 * MiB, WS_CB = 121 * MiB, WS_ACT = 186 * MiB;
constexpr size_t WS_Z = 186 * MiB, WS_G = 268 * MiB, WS_E = 301 * MiB, WS_Q2 = 186 * MiB, WS_O2 = 252 * MiB;
constexpr size_t WS_MK = 365 * MiB, WS_MVT = 367 * MiB, WS_END = 369 * MiB;
constexpr size_t CTL_CNT = 65536, CTL_ZERO = 327680, WS_RS = 53 * MiB, WS_HB = 369 * MiB, WS_CS = 434 * MiB, WS_CS4 = 438 * MiB, WS_END2 = 446 * MiB;
constexpr size_t SSM_LAMT = 0, SSM_BBF = 128 * 1024, SSM_CMF = 256 * 1024;
constexpr size_t O_PSRE = (size_t)M * D, O_PSIM = O_PSRE + 8192, O_PWK = O_PSIM + 8192, O_PWV = O_PWK + 65536, O_PMK = O_PWV + 65536, O_PMV = O_PMK + 1048576,
                 O_SSRE = O_PMV + 1048576, O_SSIM = O_SSRE + 262144, O_SWK = O_SSIM + 262144, O_SWV = O_SWK + 2097152, O_END = O_SWV + 2097152;
constexpr int LDS_BYTES = 147456;

struct Args { const float* in[43]; float* out; unsigned char* ws; int ph_lo, ph_hi; };

__device__ __forceinline__ unsigned f2bf(float f) { unsigned u = __builtin_bit_cast(unsigned, f); return (u + 0x7fffu + ((u >> 16) & 1u)) >> 16; }
__device__ __forceinline__ unsigned pk2(float lo, float hi) { return pg8::cvt_pk_bf16(lo, hi); }
__device__ __forceinline__ float bf2f(bf16 b) { return __uint_as_float((unsigned)b << 16); }
__device__ __forceinline__ float wave_sum(float v) {
    v += xl_dpp_b1(v); v += xl_dpp_4e(v); v += xl_mir8(v); v += xl_mir16(v); v += xl_xor16(v); v += xl_xor32(v);
    return v;
}
__device__ __forceinline__ float wave_max(float v) {
    v = fmaxf(v, xl_dpp_b1(v)); v = fmaxf(v, xl_dpp_4e(v)); v = fmaxf(v, xl_mir8(v)); v = fmaxf(v, xl_mir16(v)); v = fmaxf(v, xl_xor16(v)); v = fmaxf(v, xl_xor32(v));
    return v;
}
__device__ __forceinline__ void dsincos(double x, double& s, double& c) {
    const double k = rint(x * 0.63661977236758134308);
    double r = fma(-k, 1.57079632679489655800e+00, x); r = fma(-k, 6.12323399573676603587e-17, r);
    const long long q = (long long)k; const double r2 = r * r;
    double sp = -1.0 / 1307674368000.0; sp = fma(sp, r2, 1.0 / 6227020800.0); sp = fma(sp, r2, -1.0 / 39916800.0); sp = fma(sp, r2, 1.0 / 362880.0); sp = fma(sp, r2, -1.0 / 5040.0);
    sp = fma(sp, r2, 1.0 / 120.0); sp = fma(sp, r2, -1.0 / 6.0); sp = fma(sp * r2, r, r);
    double cp = 1.0 / 20922789888000.0; cp = fma(cp, r2, -1.0 / 87178291200.0); cp = fma(cp, r2, 1.0 / 479001600.0); cp = fma(cp, r2, -1.0 / 3628800.0); cp = fma(cp, r2, 1.0 / 40320.0);
    cp = fma(cp, r2, -1.0 / 720.0); cp = fma(cp, r2, 1.0 / 24.0); cp = fma(cp, r2, -0.5); cp = fma(cp, r2, 1.0);
    const int qq = (int)(q & 3);
    s = (qq == 0) ? sp : (qq == 1) ? cp : (qq == 2) ? -sp : -cp;
    c = (qq == 0) ? cp : (qq == 1) ? -sp : (qq == 2) ? -cp : sp;
}
__device__ __forceinline__ double dexp(double x) {
    const double k = rint(x * 1.4426950408889634074);
    double r = fma(-k, 6.93147180369123816490e-01, x); r = fma(-k, 1.90821492927058770002e-10, r);
    double p = 1.0;
#pragma unroll
    for (int i = 14; i >= 1; --i) p = fma(p, r * (1.0 / (double)i), 1.0);
    const long long e = (long long)k + 1023;
    return p * __longlong_as_double((long long)((unsigned long long)e << 52));
}

struct Frame {
    LAS unsigned char* lds;
    int tid, lane, wave, G;
    const float* const* in; float* out; unsigned char* ws;
};
#define INP(k) (F.in[k])
__device__ __forceinline__ const float* xrow_ptr(const Frame& F, int row) { return row < NPROW ? INP(0) + (size_t)row * D : INP(1) + (size_t)(row - NPROW) * D; }

__device__ __forceinline__ void p0_transpose_item(const float* W, int K, int N, bf16* WT, int row_off, int mode, LAS float* scr, int item, int lane, const float* gk = nullptr) {
    const int nblk = N / 32, kb = item / nblk, nb = item % nblk, k0 = 64 * kb, n0 = 32 * nb;
    const int drow0 = mode == 0 ? row_off + n0 : (256 * (n0 >> 7) + (n0 & 127) + (mode == 2 ? 128 : 0));
    float wv[32];
#pragma unroll
    for (int i = 0; i < 32; ++i) { const int kk = 2 * i + (lane >> 5); wv[i] = W[(size_t)(k0 + kk) * N + n0 + (lane & 31)]; }
#pragma unroll
    for (int i = 0; i < 32; ++i) { const int kk = 2 * i + (lane >> 5); scr[kk * 33 + (lane & 31)] = wv[i]; }
    asm volatile("s_waitcnt lgkmcnt(0)" ::: "memory");
    const int c = lane & 7;
    f32x4 ga = {1.f, 1.f, 1.f, 1.f}, gb = {1.f, 1.f, 1.f, 1.f};
    if (gk) { ga = *(const f32x4*)(gk + k0 + 8 * c); gb = *(const f32x4*)(gk + k0 + 8 * c + 4); }
#pragma unroll
    for (int j = 0; j < 4; ++j) { const int n = (lane >> 3) + 8 * j; const LAS float* s = scr + (8 * c) * 33 + n;
        v4u o; o.x = pk2(s[0 * 33] * ga.x, s[1 * 33] * ga.y); o.y = pk2(s[2 * 33] * ga.z, s[3 * 33] * ga.w); o.z = pk2(s[4 * 33] * gb.x, s[5 * 33] * gb.y); o.w = pk2(s[6 * 33] * gb.z, s[7 * 33] * gb.w);
        *(v4u*)(WT + (size_t)(drow0 + n) * K + k0 + 8 * c) = o; }
    asm volatile("s_waitcnt lgkmcnt(0)" ::: "memory");
}
__device__ __forceinline__ void rms_row_to_bf16(const Frame& F, const float* xrow, const float* g, bf16* orow) {
    const f32x4* xr = (const f32x4*)xrow + F.lane; const f32x4* gr = (const f32x4*)g + F.lane;
    f32x4 v[4]; float s = 0.f;
#pragma unroll
    for (int j = 0; j < 4; ++j) { v[j] = xr[64 * j]; s += (v[j].x * v[j].x + v[j].y * v[j].y) + (v[j].z * v[j].z + v[j].w * v[j].w); }
    const float r = 1.0f / sqrtf(wave_sum(s) * (1.f / D) + EPS);
    v2u* o8 = (v2u*)orow + F.lane;
#pragma unroll
    for (int j = 0; j < 4; ++j) { const f32x4 gg = gr[64 * j]; v2u w; w.x = pk2(v[j].x * r * gg.x, v[j].y * r * gg.y); w.y = pk2(v[j].z * r * gg.z, v[j].w * r * gg.w); o8[64 * j] = w; }
}
__device__ __forceinline__ void p0_prologue(const Frame& F) {
    LAS float* scr = (LAS float*)(F.lds + F.wave * 16384);
    const int gw = blockIdx.x * NWAVES + F.wave, NGW = F.G * NWAVES;
    bf16* const ws16 = (bf16*)F.ws;
    constexpr int I_GU = (D / 64) * (FF / 32), I_DN = (FF / 64) * (D / 32), I_IN = (D / 64) * (INW / 32), I_GL = (512 / 64) * (512 / 32), I_SQ = (D / 64) * (D / 32);
    constexpr int NITEMS = 2 * I_GU + I_DN + I_IN + I_GL + 5 * I_SQ;
    for (int it = gw; it < NITEMS; it += NGW) {
        int r = it;
        if (r < I_GU) { p0_transpose_item(INP(10), D, FF, (bf16*)(F.ws + WS_W1GU), 0, 1, scr, r, F.lane, INP(9)); continue; } r -= I_GU;
        if (r < I_GU) { p0_transpose_item(INP(11), D, FF, (bf16*)(F.ws + WS_W1GU), 0, 2, scr, r, F.lane, INP(9)); continue; } r -= I_GU;
        if (r < I_DN) { p0_transpose_item(INP(12), FF, D, (bf16*)(F.ws + WS_W1D), 0, 0, scr, r, F.lane); continue; } r -= I_DN;
        if (r < I_IN) { p0_transpose_item(INP(15), D, INW, (bf16*)(F.ws + WS_WIN), 0, 0, scr, r, F.lane, INP(14)); continue; } r -= I_IN;
        if (r < I_GL) { p0_transpose_item(INP(24), 512, 512, (bf16*)(F.ws + WS_WGLU), 0, 0, scr, r, F.lane); continue; } r -= I_GL;
        if (r < I_SQ) { p0_transpose_item(INP(29), D, D, (bf16*)(F.ws + WS_WOUT), 0, 0, scr, r, F.lane); continue; } r -= I_SQ;
        if (r < I_SQ) { p0_transpose_item(INP(32), D, D, (bf16*)(F.ws + WS_WMQ), 0, 0, scr, r, F.lane, INP(36)); continue; } r -= I_SQ;
        if (r < I_SQ) { p0_transpose_item(INP(33), D, D, (bf16*)(F.ws + WS_WMKV), 0, 0, scr, r, F.lane); continue; } r -= I_SQ;
        if (r < I_SQ) { p0_transpose_item(INP(34), D, D, (bf16*)(F.ws + WS_WMKV), 1024, 0, scr, r, F.lane); continue; } r -= I_SQ;
        p0_transpose_item(INP(35), D, D, (bf16*)(F.ws + WS_WMO), 0, 0, scr, r, F.lane);
    }
    (void)ws16;
    for (int m0 = gw; m0 < M + 1024; m0 += 4 * NGW) {
        f32x4 v[4][4];
#pragma unroll
        for (int k = 0; k < 4; ++k) { const int m = m0 + k * NGW; if (m < M + 1024) { const f32x4* xr = (const f32x4*)(m < M ? xrow_ptr(F, m) : INP(8) + (size_t)(m - M) * D) + F.lane;
#pragma unroll
            for (int j = 0; j < 4; ++j) v[k][j] = xr[64 * j]; } }
#pragma unroll
        for (int k = 0; k < 4; ++k) { const int m = m0 + k * NGW; if (m < M + 1024) {
            float sq = 0.f;
#pragma unroll
            for (int j = 0; j < 4; ++j) sq += (v[k][j].x * v[k][j].x + v[k][j].y * v[k][j].y) + (v[k][j].z * v[k][j].z + v[k][j].w * v[k][j].w);
            const float r = 1.0f / sqrtf(wave_sum(sq) * (1.f / D) + EPS);
            if (m < M) {
                if (F.lane == 0) ((float*)(F.ws + WS_RS))[m] = r;
                v2u* o8 = (v2u*)((bf16*)(F.ws + WS_HB) + (size_t)m * D) + F.lane;
#pragma unroll
                for (int j = 0; j < 4; ++j) { v2u w; w.x = pk2(v[k][j].x, v[k][j].y); w.y = pk2(v[k][j].z, v[k][j].w); o8[64 * j] = w; }
            } else {
                const f32x4* gr = (const f32x4*)INP(31) + F.lane;
                v2u* o8 = (v2u*)((bf16*)(F.ws + WS_MN) + (size_t)(m - M) * D) + F.lane;
#pragma unroll
                for (int j = 0; j < 4; ++j) { const f32x4 gg = gr[64 * j]; v2u w; w.x = pk2(v[k][j].x * r * gg.x, v[k][j].y * r * gg.y); w.y = pk2(v[k][j].z * r * gg.z, v[k][j].w * r * gg.w); o8[64 * j] = w; }
            } } }
    }
    const int gt = blockIdx.x * NTHR + F.tid, NGT = F.G * NTHR;
    for (int i = gt; i < 8196 * 8; i += NGT) {
        const int pi = i >> 3, fi = i & 7; const double pos = pi < 8192 ? (double)pi : (double)(16384 + (pi - 8192));
        const double inv = dexp(-(double)fi * 0.125 * 13.122363377404328);
        double s, c; dsincos(pos * inv, s, c);
        ((float2*)(F.ws + WS_ROPE))[i] = make_float2((float)c, (float)s);
    }
    for (int i = gt; i < 32 * 64; i += NGT) {
        const int g = i >> 6, p = i & 63;
        const double are = (double)INP(16)[i], aim = (double)INP(17)[i], dt = dexp((double)INP(18)[g]);
        float* lamt = (float*)(F.ws + WS_SSM + SSM_LAMT);
        double lbr = 0, lbi = 0;
#pragma unroll
        for (int k = 0; k < 5; ++k) { const double pw = k < 4 ? (double)(k + 1) : 128.0; const double mag = dexp(are * dt * pw); double s, c; dsincos(aim * dt * pw, s, c);
            lamt[((g * 5 + k) * 64 + p) * 2 + 0] = (float)(mag * c); lamt[((g * 5 + k) * 64 + p) * 2 + 1] = (float)(mag * s); if (k == 0) { lbr = mag * c; lbi = mag * s; } }
        const double den = are * are + aim * aim, nre = lbr - 1.0, nim = lbi;
        const double cre = (nre * are + nim * aim) / den, cim = (nim * are - nre * aim) / den;
        bf16* bbf = (bf16*)(F.ws + WS_SSM + SSM_BBF); bf16* cmf = (bf16*)(F.ws + WS_SSM + SSM_CMF);
        for (int ch = 0; ch < 16; ++ch) {
            const double bre = (double)INP(19)[(size_t)i * 16 + ch], bim = (double)INP(20)[(size_t)i * 16 + ch];
            bbf[(g * 128 + p) * 16 + ch] = (bf16)f2bf((float)(cre * bre - cim * bim));
            bbf[(g * 128 + 64 + p) * 16 + ch] = (bf16)f2bf((float)(cre * bim + cim * bre));
            cmf[(g * 16 + ch) * 128 + 4 * (p & 31) + (p >> 5)] = (bf16)f2bf(INP(21)[(g * 16 + ch) * 64 + p]);
            cmf[(g * 16 + ch) * 128 + 4 * (p & 31) + 2 + (p >> 5)] = (bf16)f2bf(-INP(22)[(g * 16 + ch) * 64 + p]);
        }
    }
}

template <bool PART> __device__ __forceinline__ void ew_rows(const Frame& F, const bf16* C, const float* gpost, float wgt, bool final, float* rs_out, int rbeg, int rend, int widx, int nw) {
    constexpr int R = 4;
    bf16* HB = (bf16*)(F.ws + WS_HB);
    f32x4 gpo[4];
#pragma unroll
    for (int j = 0; j < 4; ++j) gpo[j] = ((const f32x4*)gpost + F.lane)[64 * j];
    for (int row0 = rbeg + widx; row0 < rend; row0 += R * nw) {
        v2u hw[R][4], cw[R][4]; f32x4 cf[PART ? R : 1][4];
#pragma unroll
        for (int k = 0; k < R; ++k) { const int row = row0 + k * nw; if (row < rend) {
            const v2u* hr = (const v2u*)(HB + (size_t)row * D) + F.lane;
            if (PART) {
                const f32x4* c0 = (const f32x4*)((const float*)(F.ws + WS_CS4) + (size_t)(row - NPROW) * D) + F.lane; constexpr int PS = 512 * 1024 / 4;
#pragma unroll
                for (int j = 0; j < 4; ++j) { cf[PART ? k : 0][j] = (c0[64 * j] + c0[PS + 64 * j]) + (c0[2 * PS + 64 * j] + c0[3 * PS + 64 * j]); hw[k][j] = hr[64 * j]; }
            } else {
                const v2u* cr = (const v2u*)(C + (size_t)row * D) + F.lane;
#pragma unroll
                for (int j = 0; j < 4; ++j) { cw[k][j] = cr[64 * j]; hw[k][j] = hr[64 * j]; }
            } } }
#pragma unroll
        for (int k = 0; k < R; ++k) { const int row = row0 + k * nw; if (row < rend) {
            f32x4 c[4], h[4]; float s = 0.f;
#pragma unroll
            for (int j = 0; j < 4; ++j) { if (PART) c[j] = cf[PART ? k : 0][j]; else { const v2u w = cw[k][j]; c[j] = (f32x4){pg8::bflo(w.x), pg8::bfhi(w.x), pg8::bflo(w.y), pg8::bfhi(w.y)}; }
                s += (c[j].x * c[j].x + c[j].y * c[j].y) + (c[j].z * c[j].z + c[j].w * c[j].w); }
            const float r = wgt / sqrtf(wave_sum(s) * (1.f / D) + EPS);
            float s2 = 0.f;
#pragma unroll
            for (int j = 0; j < 4; ++j) { const v2u w = hw[k][j]; h[j] = (f32x4){pg8::bflo(w.x), pg8::bfhi(w.x), pg8::bflo(w.y), pg8::bfhi(w.y)} + c[j] * r * gpo[j];
                s2 += (h[j].x * h[j].x + h[j].y * h[j].y) + (h[j].z * h[j].z + h[j].w * h[j].w); }
            if (final) {
                f32x4* ho = (f32x4*)(F.out + (size_t)row * D) + F.lane;
#pragma unroll
                for (int j = 0; j < 4; ++j) ho[64 * j] = h[j];
            } else {
                const float r2 = 1.0f / sqrtf(wave_sum(s2) * (1.f / D) + EPS);
                if (F.lane == 0) rs_out[row] = r2;
                v2u* o8 = (v2u*)(HB + (size_t)row * D) + F.lane;
#pragma unroll
                for (int j = 0; j < 4; ++j) { v2u w; w.x = pk2(h[j].x, h[j].y); w.y = pk2(h[j].z, h[j].w); o8[64 * j] = w; }
            } } }
    }
}
__device__ __forceinline__ void mix_rows(const Frame& F, int rbeg, int rend, int widx, int nw) {
    const bf16* YO = (const bf16*)(F.ws + WS_CB); bf16* XN = (bf16*)(F.ws + WS_XN);
    f32x4 ga[2][2];
#pragma unroll
    for (int hf = 0; hf < 2; ++hf) { const float* g = (hf == 0 ? INP(27) : INP(28)) + 8 * F.lane; ga[hf][0] = *(const f32x4*)g; ga[hf][1] = *(const f32x4*)(g + 4); }
    for (int row0 = rbeg + widx; row0 < rend; row0 += 4 * nw) {
        v4u wv[4][2];
#pragma unroll
        for (int k = 0; k < 4; ++k) { const int row = row0 + k * nw; if (row < rend) {
#pragma unroll
            for (int hf = 0; hf < 2; ++hf) wv[k][hf] = *((const v4u*)(YO + (size_t)row * D + hf * 512) + F.lane); } }
#pragma unroll
        for (int k = 0; k < 4; ++k) { const int row = row0 + k * nw; if (row < rend) {
#pragma unroll
            for (int hf = 0; hf < 2; ++hf) {
                const v4u w = wv[k][hf];
                float v[8] = {pg8::bflo(w.x), pg8::bfhi(w.x), pg8::bflo(w.y), pg8::bfhi(w.y), pg8::bflo(w.z), pg8::bfhi(w.z), pg8::bflo(w.w), pg8::bfhi(w.w)};
                float sq = 0.f;
#pragma unroll
                for (int e = 0; e < 8; ++e) sq += v[e] * v[e];
                const float r = 1.0f / sqrtf(wave_sum(sq) * (1.f / 512.f) + EPS);
                const f32x4 g0 = ga[hf][0], g1 = ga[hf][1];
                v4u o; o.x = pk2(v[0] * r * g0.x, v[1] * r * g0.y); o.y = pk2(v[2] * r * g0.z, v[3] * r * g0.w); o.z = pk2(v[4] * r * g1.x, v[5] * r * g1.y); o.w = pk2(v[6] * r * g1.z, v[7] * r * g1.w);
                *((v4u*)(XN + (size_t)row * D + hf * 512) + F.lane) = o;
            } } }
    }
}

__device__ __forceinline__ float gelu_tanh(float y) {
    const float t = 0.7978845608028654f * (y + 0.044715f * y * y * y);
    const float th = 1.0f - 2.0f * __builtin_amdgcn_rcpf(1.0f + __expf(2.0f * t));
    return 0.5f * y * (1.0f + th);
}
template <bool PASS2>
__device__ __forceinline__ void ssm_unit(const Frame& F, int g, int row0, int ntok, float (&S)[4], LAS unsigned char* slds) {
    const int lane = F.lane, c = lane & 31, h = lane >> 5;
    const bf16* Z = (const bf16*)(F.ws + WS_Z);
    const bf16* bbf = (const bf16*)(F.ws + WS_SSM + SSM_BBF) + (size_t)g * 128 * 16;
    const float* lamt = (const float*)(F.ws + WS_SSM + SSM_LAMT) + (size_t)g * 5 * 64 * 2;
    bf16x8 Bf[4];
#pragma unroll
    for (int n = 0; n < 4; ++n) Bf[n] = *(const bf16x8*)(bbf + (32 * n + c) * 16 + 8 * h);
    float lr[2][4], li[2][4];
#pragma unroll
    for (int st = 0; st < 2; ++st)
#pragma unroll
        for (int k = 0; k < 4; ++k) { const float2 l = *(const float2*)(lamt + (k * 64 + 32 * st + c) * 2); lr[st][k] = l.x; li[st][k] = l.y; }
    bf16x8 Cf[4]; float dv = 0.f;
    if (PASS2) {
        const bf16* cmf = (const bf16*)(F.ws + WS_SSM + SSM_CMF) + (size_t)g * 16 * 128;
#pragma unroll
        for (int ks = 0; ks < 4; ++ks) Cf[ks] = *(const bf16x8*)(cmf + (lane & 15) * 128 + 32 * ks + 8 * (lane >> 4));
        dv = INP(23)[g * 16 + (lane & 15)];
    }
    const int nsub = (ntok + 31) >> 5, qe = ((ntok - 1) & 31) >> 2;
    float fin[4] = {0.f, 0.f, 0.f, 0.f};
    bf16x8 Unext = (bf16x8){0, 0, 0, 0, 0, 0, 0, 0};
    if (c < ntok) Unext = *(const bf16x8*)(Z + (size_t)(row0 + c) * INW + g * 16 + 8 * h);
    for (int sub = 0; sub < nsub; ++sub) {
        const int t0 = 32 * sub;
        const bf16x8 Uf = Unext;
        Unext = (bf16x8){0, 0, 0, 0, 0, 0, 0, 0};
        if (t0 + 32 + c < ntok) Unext = *(const bf16x8*)(Z + (size_t)(row0 + t0 + 32 + c) * INW + g * 16 + 8 * h);
        f32x16 a[4];
#pragma unroll
        for (int n = 0; n < 4; ++n) { f32x16 z = {}; a[n] = __builtin_amdgcn_mfma_f32_32x32x16_bf16(Uf, Bf[n], z, 0, 0, 0); }
#pragma unroll
        for (int i = 0; i < 4; ++i)
#pragma unroll
            for (int k = 1; k < 4; ++k)
#pragma unroll
                for (int st = 0; st < 2; ++st) {
                    const float pr = a[st][4 * i + k - 1], pi = a[2 + st][4 * i + k - 1];
                    a[st][4 * i + k] = fmaf(lr[st][0], pr, fmaf(-li[st][0], pi, a[st][4 * i + k]));
                    a[2 + st][4 * i + k] = fmaf(lr[st][0], pi, fmaf(li[st][0], pr, a[2 + st][4 * i + k]));
                }
        float Sin[4][4];
#pragma unroll
        for (int q = 0; q < 8; ++q) {
            const int i = q >> 1;
            if ((q & 1) == 0) {
#pragma unroll
                for (int e = 0; e < 4; ++e) Sin[i][e] = S[e];
            } else {
#pragma unroll
                for (int e = 0; e < 4; ++e) Sin[i][e] = h ? S[e] : Sin[i][e];
            }
            float o[4];
            o[0] = fmaf(lr[0][3], S[0], fmaf(-li[0][3], S[1], a[0][4 * i + 3])); o[1] = fmaf(lr[0][3], S[1], fmaf(li[0][3], S[0], a[2][4 * i + 3]));
            o[2] = fmaf(lr[1][3], S[2], fmaf(-li[1][3], S[3], a[1][4 * i + 3])); o[3] = fmaf(lr[1][3], S[3], fmaf(li[1][3], S[2], a[3][4 * i + 3]));
#pragma unroll
            for (int e = 0; e < 4; ++e) S[e] = xl_xor32(o[e]);
            if (sub == nsub - 1 && q == qe) {
#pragma unroll
                for (int e = 0; e < 4; ++e) fin[e] = S[e];
            }
        }
        float uvals[8];
        if (PASS2) {
#pragma unroll
            for (int mb = 0; mb < 2; ++mb)
#pragma unroll
                for (int r = 0; r < 4; ++r) { int tok = t0 + 16 * mb + 4 * (lane >> 4) + r; tok = tok < ntok ? tok : ntok - 1;
                    uvals[mb * 4 + r] = bf2f(Z[(size_t)(row0 + tok) * INW + g * 16 + (lane & 15)]); }
        }
        if (PASS2) {
#pragma unroll
            for (int i = 0; i < 4; ++i)
#pragma unroll
                for (int k = 0; k < 4; ++k)
#pragma unroll
                    for (int st = 0; st < 2; ++st) {
                        const float sr = Sin[i][2 * st], si = Sin[i][2 * st + 1];
                        a[st][4 * i + k] = fmaf(lr[st][k], sr, fmaf(-li[st][k], si, a[st][4 * i + k]));
                        a[2 + st][4 * i + k] = fmaf(lr[st][k], si, fmaf(li[st][k], sr, a[2 + st][4 * i + k]));
                    }
#pragma unroll
            for (int i = 0; i < 4; ++i)
#pragma unroll
                for (int k = 0; k < 4; ++k) {
                    const int tok = 8 * i + 4 * h + k; v2u w; w.x = pk2(a[0][4 * i + k], a[1][4 * i + k]); w.y = pk2(a[2][4 * i + k], a[3][4 * i + k]);
                    *(LAS v2u*)(slds + tok * 272 + c * 8) = w;
                }
            asm volatile("s_waitcnt lgkmcnt(0)" ::: "memory");
            f32x4 Y[2];
#pragma unroll
            for (int mb = 0; mb < 2; ++mb) { Y[mb] = (f32x4){0.f, 0.f, 0.f, 0.f};
#pragma unroll
                for (int ks = 0; ks < 4; ++ks) { const bf16x8 Af = *(const LAS bf16x8*)(slds + (16 * mb + (lane & 15)) * 272 + (32 * ks + 8 * (lane >> 4)) * 2);
                    Y[mb] = __builtin_amdgcn_mfma_f32_16x16x32_bf16(Af, Cf[ks], Y[mb], 0, 0, 0); } }
            asm volatile("s_waitcnt lgkmcnt(0)" ::: "memory");
            bf16* Gb = (bf16*)(F.ws + WS_G);
#pragma unroll
            for (int mb = 0; mb < 2; ++mb)
#pragma unroll
                for (int r = 0; r < 4; ++r) {
                    const int tok = t0 + 16 * mb + 4 * (lane >> 4) + r;
                    if (tok < ntok) { const size_t row = (size_t)(row0 + tok); const float uval = uvals[mb * 4 + r];
                        Gb[row * 512 + g * 16 + (lane & 15)] = (bf16)f2bf(gelu_tanh(Y[mb][r] + dv * uval)); }
                }
        }
    }
#pragma unroll
    for (int e = 0; e < 4; ++e) S[e] = fin[e];
}
__device__ __forceinline__ void ssm_pass1(const Frame& F) {
    const int gw = blockIdx.x * NWAVES + F.wave, NGW = F.G * NWAVES;
    float* E = (float*)(F.ws + WS_E);
    for (int u = gw; u < NB * 63 * 32; u += NGW) {
        const int g = u & 31, cch = (u >> 5) % 63, b = (u >> 5) / 63;
        float S[4] = {0.f, 0.f, 0.f, 0.f};
        ssm_unit<false>(F, g, b * SEQ + cch * 128, 128, S, F.lds);
        if (F.lane < 32) { float* e = E + ((size_t)(b * 32 + g) * 64 + cch) * 128 + F.lane; e[0] = S[0]; e[64] = S[1]; e[32] = S[2]; e[96] = S[3]; }
    }
}
__device__ __forceinline__ void ssm_pass2(const Frame& F) {
    const int gw = blockIdx.x * NWAVES + F.wave, NGW = F.G * NWAVES;
    const float* E = (const float*)(F.ws + WS_E);
    LAS unsigned char* slds = F.lds + F.wave * 8704;
    const int c = F.lane & 31;
    for (int u = gw; u < NB * 16 * 32 + DB * 32; u += NGW) {
        if (u < NB * 16 * 32) {
            const int g = u & 31, cq = (u >> 5) & 15, b = u >> 9;
            const float* lamt = (const float*)(F.ws + WS_SSM + SSM_LAMT) + (size_t)g * 5 * 64 * 2;
            const float2 L0 = *(const float2*)(lamt + (4 * 64 + c) * 2), L1 = *(const float2*)(lamt + (4 * 64 + 32 + c) * 2);
            float S[4] = {0.f, 0.f, 0.f, 0.f};
            const float* e = E + ((size_t)(b * 32 + g) * 64) * 128 + c;
#pragma unroll 4
            for (int j = 0; j < 4 * cq; ++j) {
                const float e0 = e[j * 128], e1 = e[j * 128 + 64], e2 = e[j * 128 + 32], e3 = e[j * 128 + 96];
                const float n0 = L0.x * S[0] - L0.y * S[1] + e0, n1 = L0.x * S[1] + L0.y * S[0] + e1, n2 = L1.x * S[2] - L1.y * S[3] + e2, n3 = L1.x * S[3] + L1.y * S[2] + e3;
                S[0] = n0; S[1] = n1; S[2] = n2; S[3] = n3;
            }
            for (int cc = 0; cc < 4; ++cc) ssm_unit<true>(F, g, b * SEQ + (4 * cq + cc) * 128, 128, S, slds);
            if (cq == 15 && F.lane < 32) { float* ore = F.out + O_PSRE + (size_t)(b * 32 + g) * 64 + c; float* oim = F.out + O_PSIM + (size_t)(b * 32 + g) * 64 + c;
                ore[0] = S[0]; oim[0] = S[1]; ore[32] = S[2]; oim[32] = S[3]; }
        } else {
            const int v = u - NB * 16 * 32, g = v & 31, b = v >> 5;
            const float* sre = INP(2) + (size_t)(b * 32 + g) * 64 + c; const float* sim = INP(3) + (size_t)(b * 32 + g) * 64 + c;
            float S[4] = {sre[0], sim[0], sre[32], sim[32]};
            ssm_unit<true>(F, g, NPROW + 4 * b, 4, S, slds);
            if (F.lane >= 32) { float* ore = F.out + O_SSRE + (size_t)(b * 32 + g) * 64 + c; float* oim = F.out + O_SSIM + (size_t)(b * 32 + g) * 64 + c;
                ore[0] = S[0]; oim[0] = S[1]; ore[32] = S[2]; oim[32] = S[3]; }
        }
    }
}

__device__ __forceinline__ void swa_prompt_unit(const Frame& F, int unit) {
    const int kvh = unit & 1, qblk = (unit >> 1) & 63, b = unit >> 7;
    const int tid = F.tid, lane = F.lane, w = F.wave, l15 = lane & 15, quad = lane >> 4;
    const bf16* Z = (const bf16*)(F.ws + WS_Z); bf16* YO = (bf16*)(F.ws + WS_CB);
    LAS unsigned char* Kl = F.lds; LAS unsigned char* Vl = F.lds + 36864;
    const int rowb = b * SEQ + qblk * 128;
    { const int d = tid >> 3, wq = tid & 7; *(LAS unsigned*)(Vl + d * 544 + 512 + 4 * wq) = 0u; }
#pragma unroll
    for (int i = 0; i < 4; ++i) {
        const int idx = tid + 512 * i, key = idx >> 3, ch = idx & 7;
        const bool inb = (qblk > 0 || key >= 128);
        const bf16* zr = Z + (size_t)(inb ? rowb - 128 + key : rowb) * INW;
        v4u kv = *(const v4u*)(zr + 1024 + kvh * 64 + ch * 8), vv = *(const v4u*)(zr + 1152 + kvh * 64 + ch * 8);
        if (!inb) { kv = (v4u){0u, 0u, 0u, 0u}; vv = (v4u){0u, 0u, 0u, 0u}; }
        *(LAS v4u*)(Kl + key * 144 + ch * 16) = kv;
        LAS unsigned short* vp = (LAS unsigned short*)(Vl + (8 * ch) * 544) + key;
        vp[0 * 272] = (unsigned short)vv.x; vp[1 * 272] = (unsigned short)(vv.x >> 16); vp[2 * 272] = (unsigned short)vv.y; vp[3 * 272] = (unsigned short)(vv.y >> 16);
        vp[4 * 272] = (unsigned short)vv.z; vp[5 * 272] = (unsigned short)(vv.z >> 16); vp[6 * 272] = (unsigned short)vv.w; vp[7 * 272] = (unsigned short)(vv.w >> 16);
        if (qblk == 63 && key >= 128) {
            float* ok = F.out + O_PWK + ((size_t)(b * 128 + key - 128) * 2 + kvh) * 64 + ch * 8; float* ov = F.out + O_PWV + ((size_t)(b * 128 + key - 128) * 2 + kvh) * 64 + ch * 8;
            *(f32x4*)ok = (f32x4){pg8::bflo(kv.x), pg8::bfhi(kv.x), pg8::bflo(kv.y), pg8::bfhi(kv.y)}; *(f32x4*)(ok + 4) = (f32x4){pg8::bflo(kv.z), pg8::bfhi(kv.z), pg8::bflo(kv.w), pg8::bfhi(kv.w)};
            *(f32x4*)ov = (f32x4){pg8::bflo(vv.x), pg8::bfhi(vv.x), pg8::bflo(vv.y), pg8::bfhi(vv.y)}; *(f32x4*)(ov + 4) = (f32x4){pg8::bflo(vv.z), pg8::bfhi(vv.z), pg8::bflo(vv.w), pg8::bfhi(vv.w)};
        }
    }
    const int hq = kvh * 4 + (w >> 1);
    const float sink = INP(26)[hq];
    bf16x8 Qa[4], Qb[4];
#pragma unroll
    for (int i = 0; i < 4; ++i) { const bf16* qrow = Z + (size_t)(rowb + (w & 1) * 64 + 16 * i + l15) * INW + 512 + hq * 64 + 8 * quad; Qa[i] = *(const bf16x8*)qrow; Qb[i] = *(const bf16x8*)(qrow + 32); }
    __syncthreads();
#pragma unroll
    for (int i = 0; i < 4; ++i) {
        const int a = (w & 1) * 64 + 16 * i, A = a >> 4, iq = a + l15;
        const bf16x8 Q0 = Qa[i], Q1 = Qb[i];
        f32x4 s[9];
#pragma unroll
        for (int nn = 0; nn < 9; ++nn) {
            const LAS unsigned char* kp = Kl + (16 * (A + nn) + l15) * 144 + 16 * quad;
            f32x4 acc = {0.f, 0.f, 0.f, 0.f};
            acc = __builtin_amdgcn_mfma_f32_16x16x32_bf16(*(const LAS bf16x8*)kp, Q0, acc, 0, 0, 0);
            acc = __builtin_amdgcn_mfma_f32_16x16x32_bf16(*(const LAS bf16x8*)(kp + 64), Q1, acc, 0, 0, 0);
            s[nn] = acc;
        }
        float mx = sink;
#pragma unroll
        for (int nn = 0; nn < 9; ++nn) {
            if (nn == 0 || nn == 8 || qblk == 0) {
#pragma unroll
                for (int r = 0; r < 4; ++r) { const int j = 16 * (A + nn) + 4 * quad + r; const bool valid = (j >= iq) && (j <= iq + 128) && (qblk > 0 || j >= 128);
                    const float v = valid ? s[nn][r] * 0.125f : -1e30f; s[nn][r] = v; mx = fmaxf(mx, v); }
            } else {
#pragma unroll
                for (int r = 0; r < 4; ++r) { const float v = s[nn][r] * 0.125f; s[nn][r] = v; mx = fmaxf(mx, v); }
            }
        }
        mx = fmaxf(mx, xl_xor16(mx)); mx = fmaxf(mx, xl_xor32(mx));
        float sum = 0.f;
#pragma unroll
        for (int nn = 0; nn < 9; ++nn)
#pragma unroll
            for (int r = 0; r < 4; ++r) { const float e = __expf(s[nn][r] - mx); s[nn][r] = e; sum += e; }
        sum += xl_xor16(sum); sum += xl_xor32(sum);
        const float inv = 1.0f / (sum + __expf(sink - mx));
        bf16x8 P[5];
#pragma unroll
        for (int kk = 0; kk < 5; ++kk) {
            v4u pw; pw.x = pk2(s[2 * kk][0] * inv, s[2 * kk][1] * inv); pw.y = pk2(s[2 * kk][2] * inv, s[2 * kk][3] * inv);
            if (kk < 4) { pw.z = pk2(s[2 * kk + 1][0] * inv, s[2 * kk + 1][1] * inv); pw.w = pk2(s[2 * kk + 1][2] * inv, s[2 * kk + 1][3] * inv); } else { pw.z = 0u; pw.w = 0u; }
            P[kk] = __builtin_bit_cast(bf16x8, pw);
        }
        f32x4 O[4];
#pragma unroll
        for (int db = 0; db < 4; ++db) { O[db] = (f32x4){0.f, 0.f, 0.f, 0.f};
#pragma unroll
            for (int kk = 0; kk < 5; ++kk) {
                const LAS unsigned char* vp = Vl + (16 * db + l15) * 544 + (16 * (A + 2 * kk) + 4 * quad) * 2;
                const v2u lo = *(const LAS v2u*)vp, hi = *(const LAS v2u*)(vp + 32);
                const v4u vf = {lo.x, lo.y, hi.x, hi.y};
                O[db] = __builtin_amdgcn_mfma_f32_16x16x32_bf16(__builtin_bit_cast(bf16x8, vf), P[kk], O[db], 0, 0, 0);
            } }
        bf16* orow = YO + (size_t)(rowb + iq) * D + 512 + hq * 64 + 4 * quad;
#pragma unroll
        for (int db = 0; db < 4; ++db) { v2u o; o.x = pk2(O[db][0], O[db][1]); o.y = pk2(O[db][2], O[db][3]); *(v2u*)(orow + 16 * db) = o; }
    }
    __syncthreads();
}
__device__ __forceinline__ void swa_sample_unit(const Frame& F, int unit) {
    const int kvh = unit & 1, b = unit >> 1, tid = F.tid, lane = F.lane, w = F.wave;
    const bf16* Z = (const bf16*)(F.ws + WS_Z); bf16* YO = (bf16*)(F.ws + WS_CB);
    LAS float* Kf = (LAS float*)F.lds;
    LAS float* Vf = (LAS float*)(F.lds + 34320);
    LAS float* Qf = (LAS float*)(F.lds + 68112);
    LAS float* Pf = (LAS float*)(F.lds + 72208) + w * 136;
    const int rowb = NPROW + 4 * b;
    for (int idx = tid; idx < 132 * 16; idx += NTHR) {
        const int j = idx >> 4, c4 = (idx & 15) * 4;
        f32x4 kv, vv;
        if (j < 128) { kv = *(const f32x4*)(INP(4) + ((size_t)(b * 128 + j) * 2 + kvh) * 64 + c4); vv = *(const f32x4*)(INP(5) + ((size_t)(b * 128 + j) * 2 + kvh) * 64 + c4); }
        else { const bf16* zr = Z + (size_t)(rowb + j - 128) * INW; const v2u kw = *(const v2u*)(zr + 1024 + kvh * 64 + c4), vw = *(const v2u*)(zr + 1152 + kvh * 64 + c4);
            kv = (f32x4){pg8::bflo(kw.x), pg8::bfhi(kw.x), pg8::bflo(kw.y), pg8::bfhi(kw.y)}; vv = (f32x4){pg8::bflo(vw.x), pg8::bfhi(vw.x), pg8::bflo(vw.y), pg8::bfhi(vw.y)}; }
        Kf[j * 65 + c4] = kv.x; Kf[j * 65 + c4 + 1] = kv.y; Kf[j * 65 + c4 + 2] = kv.z; Kf[j * 65 + c4 + 3] = kv.w;
        *(LAS f32x4*)(Vf + j * 64 + c4) = vv;
        if (j >= 4) { *(f32x4*)(F.out + O_SWK + ((size_t)(b * 128 + j - 4) * 2 + kvh) * 64 + c4) = kv; *(f32x4*)(F.out + O_SWV + ((size_t)(b * 128 + j - 4) * 2 + kvh) * 64 + c4) = vv; }
    }
    for (int idx = tid; idx < 16 * 64; idx += NTHR) { const int qr = idx >> 6, d = idx & 63, t = qr >> 2, hl = qr & 3;
        Qf[idx] = 0.125f * bf2f(Z[(size_t)(rowb + t) * INW + 512 + (kvh * 4 + hl) * 64 + d]); }
    __syncthreads();
    const int hl = w & 3, hq = kvh * 4 + hl; const float sink = INP(26)[hq];
    for (int tt = 0; tt < 2; ++tt) {
        const int t = 2 * (w >> 2) + tt; const LAS float* q = Qf + (t * 4 + hl) * 64;
        float s[3]; float mx = sink;
#pragma unroll
        for (int cc = 0; cc < 3; ++cc) { const int j = lane + 64 * cc; float acc = 0.f;
            if (j < 132) { const LAS float* kr = Kf + j * 65;
#pragma unroll 16
                for (int d = 0; d < 64; ++d) acc += q[d] * kr[d]; }
            const bool valid = (j < 132) && (j >= t) && (j <= 128 + t); s[cc] = valid ? acc : -1e30f; mx = fmaxf(mx, s[cc]); }
        mx = wave_max(mx);
        float sum = 0.f;
#pragma unroll
        for (int cc = 0; cc < 3; ++cc) { s[cc] = __expf(s[cc] - mx); sum += s[cc]; }
        sum = wave_sum(sum);
        const float inv = 1.0f / (sum + __expf(sink - mx));
#pragma unroll
        for (int cc = 0; cc < 3; ++cc) { const int j = lane + 64 * cc; if (j < 132) Pf[j] = s[cc] * inv; }
        asm volatile("s_waitcnt lgkmcnt(0)" ::: "memory");
        float o = 0.f;
#pragma unroll 4
        for (int j = 0; j < 132; ++j) o += Pf[j] * Vf[j * 64 + lane];
        YO[(size_t)(rowb + t) * D + 512 + hq * 64 + lane] = (bf16)f2bf(o);
        asm volatile("s_waitcnt lgkmcnt(0)" ::: "memory");
    }
    __syncthreads();
}

__device__ __forceinline__ void xattn_prompt_unit(const Frame& F, int unit) {
    const int qb = unit & 31, hd = (unit >> 5) & 3, b = unit >> 7;
    const int tid = F.tid, lane = F.lane, w = F.wave, l15 = lane & 15, quad = lane >> 4;
    const bf16* Q2 = (const bf16*)(F.ws + WS_Q2); bf16* O2 = (bf16*)(F.ws + WS_O2);
    const bf16* MK = (const bf16*)(F.ws + WS_MK); const bf16* MVT = (const bf16*)(F.ws + WS_MVT);
    LAS unsigned char* L = F.lds;
    const int rowb = b * SEQ + qb * 256 + w * 32;
#pragma unroll
    for (int i = 0; i < 16; ++i) { const int idx = tid + 512 * i, key = idx >> 5, ch = idx & 31;
        *(LAS v4u*)(L + key * 528 + ch * 16) = *(const v4u*)(MK + (size_t)(b * 256 + key) * 1024 + hd * 256 + ch * 8); }
    __syncthreads();
    bf16x8 P[2][8];
#pragma unroll
    for (int qi = 0; qi < 2; ++qi) {
        const bf16* qrow = Q2 + (size_t)(rowb + qi * 16 + l15) * D + hd * 256 + 8 * quad;
        bf16x8 Qf[8];
#pragma unroll
        for (int ks = 0; ks < 8; ++ks) Qf[ks] = *(const bf16x8*)(qrow + 32 * ks);
        f32x4 s[16]; float mx = -1e30f;
#pragma unroll
        for (int kb = 0; kb < 16; ++kb) { f32x4 acc = {0.f, 0.f, 0.f, 0.f}; const LAS unsigned char* kp = L + (16 * kb + l15) * 528 + 16 * quad;
#pragma unroll
            for (int ks = 0; ks < 8; ++ks) acc = __builtin_amdgcn_mfma_f32_16x16x32_bf16(*(const LAS bf16x8*)(kp + 64 * ks), Qf[ks], acc, 0, 0, 0);
            s[kb] = acc; mx = fmaxf(fmaxf(mx, fmaxf(acc[0], acc[1])), fmaxf(acc[2], acc[3])); if (kb & 1) __builtin_amdgcn_sched_barrier(0); }
        mx = fmaxf(mx, xl_xor16(mx)); mx = fmaxf(mx, xl_xor32(mx));
        float sum = 0.f;
#pragma unroll
        for (int kb = 0; kb < 16; ++kb)
#pragma unroll
            for (int r = 0; r < 4; ++r) { const float e = __expf((s[kb][r] - mx) * 0.0625f); s[kb][r] = e; sum += e; }
        sum += xl_xor16(sum); sum += xl_xor32(sum);
        const float inv = 1.0f / sum;
#pragma unroll
        for (int kk = 0; kk < 8; ++kk) { v4u pw; pw.x = pk2(s[2 * kk][0] * inv, s[2 * kk][1] * inv); pw.y = pk2(s[2 * kk][2] * inv, s[2 * kk][3] * inv);
            pw.z = pk2(s[2 * kk + 1][0] * inv, s[2 * kk + 1][1] * inv); pw.w = pk2(s[2 * kk + 1][2] * inv, s[2 * kk + 1][3] * inv); P[qi][kk] = __builtin_bit_cast(bf16x8, pw); }
    }
    __syncthreads();
#pragma unroll
    for (int i = 0; i < 16; ++i) { const int idx = tid + 512 * i, d = idx >> 5, ch = idx & 31;
        *(LAS v4u*)(L + d * 528 + ch * 16) = *(const v4u*)(MVT + ((size_t)(b * 4 + hd) * 256 + d) * 256 + ch * 8); }
    __syncthreads();
#pragma unroll
    for (int qi = 0; qi < 2; ++qi) {
        f32x4 O[16];
#pragma unroll
        for (int db = 0; db < 16; ++db) O[db] = (f32x4){0.f, 0.f, 0.f, 0.f};
#pragma unroll
        for (int kk = 0; kk < 8; ++kk) {
#pragma unroll
            for (int db = 0; db < 16; ++db) { const LAS unsigned char* vp = L + (16 * db + l15) * 528 + (32 * kk + 4 * quad) * 2;
                const v2u lo = *(const LAS v2u*)vp, hi = *(const LAS v2u*)(vp + 32); const v4u vf = {lo.x, lo.y, hi.x, hi.y};
                O[db] = __builtin_amdgcn_mfma_f32_16x16x32_bf16(__builtin_bit_cast(bf16x8, vf), P[qi][kk], O[db], 0, 0, 0);
                if ((db & 7) == 7) __builtin_amdgcn_sched_barrier(0); } }
        bf16* orow = O2 + (size_t)(rowb + qi * 16 + l15) * D + hd * 256 + 4 * quad;
#pragma unroll
        for (int db = 0; db < 16; ++db) { v2u o; o.x = pk2(O[db][0], O[db][1]); o.y = pk2(O[db][2], O[db][3]); *(v2u*)(orow + 16 * db) = o; }
    }
    __syncthreads();
}
__device__ __forceinline__ void xattn_sample_unit(const Frame& F, int unit) {
    const int hd = unit & 3, b = unit >> 2, tid = F.tid, lane = F.lane, w = F.wave;
    const bf16* Q2 = (const bf16*)(F.ws + WS_Q2); bf16* O2 = (bf16*)(F.ws + WS_O2);
    LAS float* OP = (LAS float*)F.lds;
    LAS float* ML = (LAS float*)(F.lds + 32768);
    const int rowb = NPROW + 4 * b;
    f32x4 q[4];
#pragma unroll
    for (int t = 0; t < 4; ++t) {
        const float* c0 = (const float*)(F.ws + WS_CS) + (size_t)(4 * b + t) * D + hd * 256 + 4 * lane;
        q[t] = (*(const f32x4*)c0 + *(const f32x4*)(c0 + 512 * 1024)) * ((const float*)(F.ws + WS_RS))[(size_t)2 * M + rowb + t]; }
    const float* kbase = INP(6) + ((size_t)(b * 256 + w * 32) * 4 + hd) * 256 + 4 * lane;
    const float* vbase = INP(7) + ((size_t)(b * 256 + w * 32) * 4 + hd) * 256 + 4 * lane;
    float scb[2];
#pragma unroll
    for (int bb = 0; bb < 2; ++bb) {
        float v[64];
#pragma unroll
        for (int i = 0; i < 16; ++i) { const f32x4 kv = *(const f32x4*)(kbase + (size_t)(16 * bb + i) * 1024);
#pragma unroll
            for (int t = 0; t < 4; ++t) v[4 * i + t] = (q[t].x * kv.x + q[t].y * kv.y) + (q[t].z * kv.z + q[t].w * kv.w); }
        const bool b0 = lane & 1, b1 = lane & 2, b2 = lane & 4, b3 = lane & 8, b4 = lane & 16, b5 = lane & 32;
#pragma unroll
        for (int j = 0; j < 32; ++j) { const float a = v[2 * j], c = v[2 * j + 1]; v[j] = (b0 ? c : a) + xl_dpp_b1(b0 ? a : c); }
#pragma unroll
        for (int j = 0; j < 16; ++j) { const float a = v[2 * j], c = v[2 * j + 1]; v[j] = (b1 ? c : a) + xl_dpp_4e(b1 ? a : c); }
#pragma unroll
        for (int j = 0; j < 8; ++j) { const float a = v[2 * j], c = v[2 * j + 1]; v[j] = (b2 ? c : a) + __shfl_xor(b2 ? a : c, 4); }
#pragma unroll
        for (int j = 0; j < 4; ++j) { const float a = v[2 * j], c = v[2 * j + 1]; v[j] = (b3 ? c : a) + __shfl_xor(b3 ? a : c, 8); }
#pragma unroll
        for (int j = 0; j < 2; ++j) { const float a = v[2 * j], c = v[2 * j + 1]; v[j] = (b4 ? c : a) + xl_xor16(b4 ? a : c); }
        scb[bb] = ((b5 ? v[1] : v[0]) + xl_xor32(b5 ? v[0] : v[1])) * 0.0625f;
    }
    f32x4 vpre[8];
#pragma unroll
    for (int i = 0; i < 8; ++i) vpre[i] = *(const f32x4*)(vbase + (size_t)i * 1024);
    float mq = fmaxf(scb[0], scb[1]);
    mq = fmaxf(mq, __shfl_xor(mq, 4)); mq = fmaxf(mq, __shfl_xor(mq, 8)); mq = fmaxf(mq, xl_xor16(mq)); mq = fmaxf(mq, xl_xor32(mq));
    float e0 = __expf(scb[0] - mq), e1 = __expf(scb[1] - mq);
    float lq = e0 + e1;
    lq += __shfl_xor(lq, 4); lq += __shfl_xor(lq, 8); lq += xl_xor16(lq); lq += xl_xor32(lq);
    float mloc[4], lloc[4];
#pragma unroll
    for (int t = 0; t < 4; ++t) { mloc[t] = __uint_as_float(__builtin_amdgcn_readlane(__float_as_uint(mq), t)); lloc[t] = __uint_as_float(__builtin_amdgcn_readlane(__float_as_uint(lq), t)); }
    f32x4 o[4];
#pragma unroll
    for (int t = 0; t < 4; ++t) o[t] = (f32x4){0.f, 0.f, 0.f, 0.f};
#pragma unroll
    for (int i = 0; i < 32; ++i) {
        const f32x4 vv = i < 8 ? vpre[i] : *(const f32x4*)(vbase + (size_t)i * 1024);
#pragma unroll
        for (int t = 0; t < 4; ++t) { const float pp = __uint_as_float(__builtin_amdgcn_readlane(__float_as_uint(i < 16 ? e0 : e1), 4 * (i & 15) + t)); o[t] = o[t] + vv * pp; } }
#pragma unroll
    for (int t = 0; t < 4; ++t) { *(LAS f32x4*)(OP + (w * 4 + t) * 256 + 4 * lane) = o[t]; if (lane == 0) { ML[(w * 4 + t) * 2] = mloc[t]; ML[(w * 4 + t) * 2 + 1] = lloc[t]; } }
    __syncthreads();
#pragma unroll
    for (int k = 0; k < 2; ++k) { const int idx = tid + 512 * k, t = idx >> 8, d = idx & 255;
        float mm = -1e30f;
#pragma unroll
        for (int ww = 0; ww < 8; ++ww) mm = fmaxf(mm, ML[(ww * 4 + t) * 2]);
        float L = 0.f, acc = 0.f;
#pragma unroll
        for (int ww = 0; ww < 8; ++ww) { const float f = __expf(ML[(ww * 4 + t) * 2] - mm); L += ML[(ww * 4 + t) * 2 + 1] * f; acc += OP[(ww * 4 + t) * 256 + d] * f; }
        O2[(size_t)(rowb + t) * D + hd * 256 + d] = (bf16)f2bf(acc / L); }
    __syncthreads();
}

#define XB_TMO      128
#define XB_XCNT(j)  (256  + 64 * (j))
#define XB_XSUB(j)  (1280 + 64 * (j))
#define XB_XGEN(j)  (2304 + 64 * (j))
#define XB_TOP      3328
#define XB_TOPGEN   3392
#define XCD_BAR_WORDS 3456
#define XB_SPIN_CAP (1u << 18)

__device__ __forceinline__ unsigned xb_ld(unsigned* p)              { return __hip_atomic_load(p, __ATOMIC_RELAXED, __HIP_MEMORY_SCOPE_AGENT); }
__device__ __forceinline__ unsigned xb_add(unsigned* p, unsigned v) { return __hip_atomic_fetch_add(p, v, __ATOMIC_RELAXED, __HIP_MEMORY_SCOPE_AGENT); }
__device__ __forceinline__ unsigned xb_xcc_id() { return (unsigned)__builtin_amdgcn_s_getreg((3 << 11) | 20) & 0xFu; }
#define XB_SPIN(cond, bar) do { unsigned _sp = 0; while (cond) { __builtin_amdgcn_s_sleep(1); \
    if ((++_sp & 255u) == 0u) { if (xb_ld(&(bar)[XB_TMO])) break; if (_sp > XB_SPIN_CAP) { atomicAdd(&(bar)[XB_TMO], 1u); break; } } } } while (0)

struct XcdBarrier {
    unsigned* bar; unsigned x;
    volatile LAS unsigned* st;
};

__device__ __forceinline__ XcdBarrier xcd_barrier_post(unsigned* bar, volatile LAS unsigned* st) {
    XcdBarrier b; b.bar = bar; b.x = xb_xcc_id(); b.st = st;
    if (threadIdx.x == 0) (void)xb_add(&bar[XB_XCNT(b.x)], 1u);
    return b;
}
__device__ __forceinline__ void xcd_barrier_complete(unsigned* bar, unsigned x, unsigned& nloc, unsigned& nx) {
    const unsigned G = gridDim.x * gridDim.y * gridDim.z;
    unsigned sum, cnt, mine, sp = 0u;
    for (;;) {
        sum = 0u; cnt = 0u; mine = 0u;
#pragma unroll
        for (unsigned j = 0; j < 16; ++j) { const unsigned c = xb_ld(&bar[XB_XCNT(j)]); sum += c; cnt += (c > 0u) ? 1u : 0u; mine = (j == x) ? c : mine; }
        if (sum == G) break;
        __builtin_amdgcn_s_sleep(1);
        if ((++sp & 255u) == 0u) { if (xb_ld(&bar[XB_TMO])) break; if (sp > XB_SPIN_CAP) { atomicAdd(&bar[XB_TMO], 1u); break; } }
    }
    nloc = mine > 0u ? mine : 1u; nx = cnt > 0u ? cnt : 1u;
}

__device__ __forceinline__ void xcd_barrier(const XcdBarrier& b) {
    asm volatile("s_waitcnt vmcnt(0)" ::: "memory");
    __syncthreads();
    if (threadIdx.x == 0) {
        unsigned* bar = b.bar;
        __builtin_amdgcn_s_waitcnt(0);
        unsigned nloc = b.st[0], nx = b.st[1];
        if (nloc == 0u) { xcd_barrier_complete(bar, b.x, nloc, nx); b.st[0] = nloc; b.st[1] = nx; }
        const unsigned old = xb_add(&bar[XB_XSUB(b.x)], 1u);
        const unsigned gen = old / nloc;
        if (old + 1u == (gen + 1u) * nloc) {
            __builtin_amdgcn_fence(__ATOMIC_RELEASE, "agent");
            asm volatile("s_waitcnt vmcnt(0)" ::: "memory");
            const unsigned og = xb_add(&bar[XB_TOP], 1u);
            const unsigned tg = og / nx;
            if (og + 1u == (tg + 1u) * nx) xb_add(&bar[XB_TOPGEN], 1u);
            else XB_SPIN(xb_ld(&bar[XB_TOPGEN]) == tg, bar);
            __builtin_amdgcn_fence(__ATOMIC_ACQUIRE, "agent");
            xb_add(&bar[XB_XGEN(b.x)], 1u);
            asm volatile("s_waitcnt vmcnt(0)" ::: "memory");
        } else {
            XB_SPIN(xb_ld(&bar[XB_XGEN(b.x)]) == gen, bar);
            __builtin_amdgcn_fence(__ATOMIC_ACQUIRE, "agent");
            asm volatile("s_waitcnt vmcnt(0)" ::: "memory");
        }
    }
    __syncthreads();
}

__device__ __forceinline__ void run_gu(const Frame& F, size_t woff, int rsi, int cid) {
    pg8::Gemm g{(const bf16*)(F.ws + WS_HB), (const bf16*)(F.ws + woff), M, 2 * FF, D}; pg8::StaticOrder S; S.init(M, 2 * FF, F.G, cid);
    pg8::EpiSwiglu E{(bf16*)(F.ws + WS_ACT), FF, (const float*)(F.ws + WS_RS) + (size_t)rsi * M};
    pg8::gemm_phase<pg8::EpiSwiglu, pg8::StaticOrder, true, true>(F.lds, g, S, E);
}
__device__ __forceinline__ void run_plain(const Frame& F, size_t aoff, size_t boff, size_t ooff, int K, int rsi, int cid) {
    pg8::Gemm g{(const bf16*)(F.ws + aoff), (const bf16*)(F.ws + boff), M, D, K}; pg8::StaticOrder S; S.init(M, D, F.G, cid);
    pg8::EpiPlain E{(bf16*)(F.ws + ooff), D, (const float*)(F.ws + WS_RS) + (size_t)rsi * M};
    pg8::gemm_phase<pg8::EpiPlain, pg8::StaticOrder, true, true>(F.lds, g, S, E);
}

__device__ __forceinline__ void run_gemm_ew(const Frame& F, size_t aoff, size_t boff, int K, int which, const float* gpost, float wgt, bool final, int cid) {
    const int vc = (F.G % 8 == 0) ? (cid % 8) * (F.G / 8) + cid / 8 : cid;
    unsigned* cntP = (unsigned*)(F.ws + CTL_CNT) + (size_t)which * (130 * 64);
    unsigned* cntB = cntP + 128 * 64;
    { pg8::Gemm g{(const bf16*)(F.ws + aoff), (const bf16*)(F.ws + boff), NPROW, D, K, K}; pg8::PanelOrder S; S.init(NPROW, F.G, vc);
      pg8::EpiPlainCnt E{(bf16*)(F.ws + WS_CB), D, cntP, cntB};
      pg8::gemm_phase<pg8::EpiPlainCnt, pg8::PanelOrder, true, true>(F.lds, g, S, E); }
    const bool late = (vc & 7) == 0; const int li = vc >> 3;
    if (late) {
        const int part = li & 3, nt = K / 64, q2 = (nt / 4) & ~1, big = (nt - 4 * q2) / 2;
        const int len = (part < big ? q2 + 2 : q2) * 64, k0 = (part * q2 + 2 * (part < big ? part : big)) * 64;
        pg8::Gemm g{(const bf16*)(F.ws + aoff), (const bf16*)(F.ws + boff), M, D, len, K}; pg8::SampleSplit4Order S{li, k0};
        pg8::EpiPart4F32 E{(float*)(F.ws + WS_CS4), part, cntB};
        pg8::gemm_phase<pg8::EpiPart4F32, pg8::SampleSplit4Order, true, true>(F.lds, g, S, E); }
    float* rs_out = (float*)(F.ws + WS_RS) + (size_t)(which + 1) * M;
    const int p0 = vc >> 2, p1 = (F.G + vc) >> 2;
    if (F.tid == 0) { unsigned sp = 0;
        while (__hip_atomic_load(cntP + 64 * p0, __ATOMIC_RELAXED, __HIP_MEMORY_SCOPE_AGENT) < 4u || __hip_atomic_load(cntP + 64 * p1, __ATOMIC_RELAXED, __HIP_MEMORY_SCOPE_AGENT) < 4u) { __builtin_amdgcn_s_sleep(4); if (++sp > (1u << 24)) break; }
        __builtin_amdgcn_fence(__ATOMIC_ACQUIRE, "agent"); asm volatile("s_waitcnt vmcnt(0)" ::: "memory"); }
    __syncthreads();
    if (!late) {
        const int q = vc & 3;
        ew_rows<false>(F, (const bf16*)(F.ws + WS_CB), gpost, wgt, final, rs_out, p0 * 256 + q * 64, p0 * 256 + q * 64 + 64, F.wave, NWAVES);
        ew_rows<false>(F, (const bf16*)(F.ws + WS_CB), gpost, wgt, final, rs_out, p1 * 256 + q * 64, p1 * 256 + q * 64 + 64, F.wave, NWAVES);
        if ((vc & 4) == 0) {
            ew_rows<false>(F, (const bf16*)(F.ws + WS_CB), gpost, wgt, final, rs_out, p0 * 256, p0 * 256 + 64, (q - 1) + 3 * F.wave, 3 * NWAVES);
            ew_rows<false>(F, (const bf16*)(F.ws + WS_CB), gpost, wgt, final, rs_out, p1 * 256, p1 * 256 + 64, (q - 1) + 3 * F.wave, 3 * NWAVES);
        }
    }
    if (late) {
        if (F.tid == 0) { unsigned sp = 0; while (__hip_atomic_load(cntB, __ATOMIC_RELAXED, __HIP_MEMORY_SCOPE_AGENT) < 32u) { __builtin_amdgcn_s_sleep(4); if (++sp > (1u << 24)) break; }
            __builtin_amdgcn_fence(__ATOMIC_ACQUIRE, "agent"); asm volatile("s_waitcnt vmcnt(0)" ::: "memory"); }
        __syncthreads();
        ew_rows<true>(F, (const bf16*)(F.ws + WS_CB), gpost, wgt, final, rs_out, NPROW, M, li * NWAVES + F.wave, 32 * NWAVES);
    }
}
__device__ __forceinline__ void convert_ffn2_weights(const Frame& F, int widx, int nw) {
    LAS float* scr = (LAS float*)(F.lds + F.wave * 16384);
    constexpr int I_GU = (D / 64) * (FF / 32), I_DN = (FF / 64) * (D / 32);
    for (int it = widx; it < 2 * I_GU + I_DN; it += nw) {
        int r = it;
        if (r < I_GU) { p0_transpose_item(INP(39), D, FF, (bf16*)(F.ws + WS_W2GU), 0, 1, scr, r, F.lane, INP(38)); continue; } r -= I_GU;
        if (r < I_GU) { p0_transpose_item(INP(40), D, FF, (bf16*)(F.ws + WS_W2GU), 0, 2, scr, r, F.lane, INP(38)); continue; } r -= I_GU;
        p0_transpose_item(INP(41), FF, D, (bf16*)(F.ws + WS_W2D), 0, 0, scr, r, F.lane);
    }
}
enum { PH_P0 = 0, PH_GU1, PH_DN1, PH_WIN, PH_MIXA, PH_SSM2, PH_GLU, PH_WOUT, PH_MEMQ, PH_XATT, PH_MEMO, PH_GU2, PH_DN2, PH_COUNT };

__global__ void __launch_bounds__(NTHR, 2) fwd_megakernel(Args args) {
    extern __shared__ __attribute__((aligned(16))) unsigned char lds_raw[];
    cg::grid_group grid = cg::this_grid();
    Frame F;
    F.lds = (LAS unsigned char*)lds_raw;
    F.tid = threadIdx.x; F.lane = F.tid & 63; F.wave = __builtin_amdgcn_readfirstlane(F.tid >> 6); F.G = gridDim.x;
    F.in = args.in; F.out = args.out; F.ws = args.ws;
    unsigned char* ws = args.ws;
    const int cid = (int)blockIdx.x;
    volatile LAS unsigned* MISC = (volatile LAS unsigned*)(F.lds + LDS_BYTES - 256);
    if (F.tid < 64) MISC[F.tid] = 0u;
    __syncthreads();
    XcdBarrier bar = xcd_barrier_post((unsigned*)ws, MISC + 8);
    const int lo = args.ph_lo, hi = args.ph_hi;
#define IN_PH(k) (lo <= (k) && (k) < hi)
#define SEAM(k) do { if (IN_PH(k) && IN_PH((k) + 1)) xcd_barrier(bar); } while (0)
    if (hi > PH_COUNT) grid.sync();
    if (IN_PH(PH_P0)) p0_prologue(F);
    SEAM(PH_P0);
    if (IN_PH(PH_GU1)) {
        run_gu(F, WS_W1GU, 0, cid);
        const int nlast = (M / 256) * (2 * FF / 256) % F.G;
        if (cid >= nlast) convert_ffn2_weights(F, (cid - nlast) * NWAVES + F.wave, (F.G - nlast) * NWAVES);
    }
    SEAM(PH_GU1);
    if (IN_PH(PH_DN1)) run_gemm_ew(F, WS_ACT, WS_W1D, FF, 0, INP(13), 0.5f, false, cid);
    SEAM(PH_DN1);
    if (IN_PH(PH_WIN)) {
        { pg8::Gemm g{(const bf16*)(ws + WS_HB), (const bf16*)(ws + WS_WIN), M, INW, D}; pg8::StaticOrder S; S.init(M, INW, F.G, cid);
          pg8::EpiWin E{(bf16*)(ws + WS_Z), (const float2*)(ws + WS_ROPE), (const float*)(ws + WS_RS) + (size_t)1 * M, F.lds + 131072};
          pg8::gemm_phase<pg8::EpiWin, pg8::StaticOrder, true, true>(F.lds, g, S, E); }
        { pg8::Gemm g{(const bf16*)(ws + WS_MN), (const bf16*)(ws + WS_WMKV), 1024, 2048, D}; pg8::StaticOrder S; S.init(1024, 2048, F.G, (cid + F.G - (650 % F.G)) % F.G);
          pg8::EpiMemKV E{F.out + O_PMK, F.out + O_PMV, (bf16*)(ws + WS_MK), (bf16*)(ws + WS_MVT)};
          pg8::gemm_phase<pg8::EpiMemKV, pg8::StaticOrder, true, true>(F.lds, g, S, E); }
    }
    SEAM(PH_WIN);
    if (IN_PH(PH_MIXA)) {
        { const int vcw = (F.G % 8 == 0) ? (cid % 8) * (F.G / 8) + cid / 8 : cid; for (int u = vcw; u < 512; u += F.G) swa_prompt_unit(F, u); }
        for (int u = cid; u < 256; u += F.G) swa_sample_unit(F, u);
        ssm_pass1(F);
    }
    SEAM(PH_MIXA);
    if (IN_PH(PH_SSM2)) ssm_pass2(F);
    SEAM(PH_SSM2);
    if (IN_PH(PH_GLU)) {
        const int vc = (F.G % 8 == 0) ? (cid % 8) * (F.G / 8) + cid / 8 : cid;
        unsigned* cnt = (unsigned*)(ws + CTL_CNT) + (size_t)5 * (130 * 64);
        const bool late = (vc & 63) == 0; const int li = vc >> 6;
        { pg8::Gemm g{(const bf16*)(ws + WS_G), (const bf16*)(ws + WS_WGLU), NPROW, 512, 512, 512}; pg8::PanelOrder2 S{vc};
          pg8::EpiGlu E{(const bf16*)(ws + WS_G), INP(25), (bf16*)(ws + WS_CB), D, cnt};
          pg8::gemm_phase<pg8::EpiGlu, pg8::PanelOrder2, true, true>(F.lds, g, S, E); }
        if (late) { pg8::Gemm g{(const bf16*)(ws + WS_G), (const bf16*)(ws + WS_WGLU), M, 512, 512, 512}; pg8::OneUnitOrder S{128 + (li >> 1), li & 1};
          pg8::EpiGlu E{(const bf16*)(ws + WS_G), INP(25), (bf16*)(ws + WS_CB), D, cnt};
          pg8::gemm_phase<pg8::EpiGlu, pg8::OneUnitOrder, true, true>(F.lds, g, S, E); }
        const int pmw = late ? 128 + (li >> 1) : (vc >> 1);
        if (F.tid == 0) { unsigned sp = 0; while (__hip_atomic_load(cnt + 64 * pmw, __ATOMIC_RELAXED, __HIP_MEMORY_SCOPE_AGENT) < 2u) { __builtin_amdgcn_s_sleep(4); if (++sp > (1u << 24)) break; }
            __builtin_amdgcn_fence(__ATOMIC_ACQUIRE, "agent"); asm volatile("s_waitcnt vmcnt(0)" ::: "memory"); }
        __syncthreads();
        if (late) mix_rows(F, pmw * 256 + (li & 1) * 128, pmw * 256 + (li & 1) * 128 + 128, F.wave, NWAVES);
        else if ((vc & 63) == 1) mix_rows(F, pmw * 256, pmw * 256 + 256, F.wave, NWAVES);
        else mix_rows(F, pmw * 256 + (vc & 1) * 128, pmw * 256 + (vc & 1) * 128 + 128, F.wave, NWAVES);
    }
    SEAM(PH_GLU);
    if (IN_PH(PH_WOUT)) run_gemm_ew(F, WS_XN, WS_WOUT, D, 1, INP(30), 1.0f, false, cid);
    SEAM(PH_WOUT);
    if (IN_PH(PH_MEMQ)) {
        const int vc = (F.G % 8 == 0) ? (cid % 8) * (F.G / 8) + cid / 8 : cid;
        if ((vc & 15) == 0) { pg8::Gemm g{(const bf16*)(ws + WS_HB), (const bf16*)(ws + WS_WMQ), M, D, D / 2, D}; pg8::SampleSplitOrder S{vc >> 4, D / 2};
          pg8::EpiPartF32 E{(float*)(ws + WS_CS), D / 2, (unsigned*)(ws + CTL_CNT) + (size_t)4 * (130 * 64)};
          pg8::gemm_phase<pg8::EpiPartF32, pg8::SampleSplitOrder, true, true>(F.lds, g, S, E); }
        { pg8::Gemm g{(const bf16*)(ws + WS_HB), (const bf16*)(ws + WS_WMQ), NPROW, D, D, D}; pg8::StaticOrder S; S.init(NPROW, D, F.G, cid);
          pg8::EpiPlain E{(bf16*)(ws + WS_Q2), D, (const float*)(ws + WS_RS) + (size_t)2 * M};
          pg8::gemm_phase<pg8::EpiPlain, pg8::StaticOrder, true, true>(F.lds, g, S, E); }
    }
    SEAM(PH_MEMQ);
    if (IN_PH(PH_XATT)) {
        const int vcx = (F.G % 8 == 0) ? (cid % 8) * (F.G / 8) + cid / 8 : cid;
        if (vcx & 1) { for (int u = cid; u < 512; u += F.G) xattn_sample_unit(F, u); for (int u = vcx; u < 512; u += F.G) xattn_prompt_unit(F, u); }
        else { for (int u = vcx; u < 512; u += F.G) xattn_prompt_unit(F, u); for (int u = cid; u < 512; u += F.G) xattn_sample_unit(F, u); }
    }
    SEAM(PH_XATT);
    if (IN_PH(PH_MEMO)) run_gemm_ew(F, WS_O2, WS_WMO, D, 2, INP(37), 1.0f, false, cid);
    SEAM(PH_MEMO);
    if (IN_PH(PH_GU2)) run_gu(F, WS_W2GU, 3, cid);
    SEAM(PH_GU2);
    if (IN_PH(PH_DN2)) run_gemm_ew(F, WS_ACT, WS_W2D, FF, 3, INP(42), 0.5f, true, cid);
}

extern "C" void kernel_launch(void* const* d_in, const int* in_sizes, int n_in, void* d_out, int out_size, void* d_ws, size_t ws_size, hipStream_t stream) {
    static int grid = 0;
    if (grid == 0) {
        if (n_in != 43 || out_size != (int)O_END || ws_size < WS_END2) { fprintf(stderr, "kernel_launch: unexpected sizes n_in %d out %d ws %zu\n", n_in, out_size, ws_size); grid = -1; return; }
        int dev = 0, cus = 0, per_cu = 0;
        hipGetDevice(&dev); hipDeviceGetAttribute(&cus, hipDeviceAttributeMultiprocessorCount, dev);
        hipFuncSetAttribute((const void*)fwd_megakernel, hipFuncAttributeMaxDynamicSharedMemorySize, LDS_BYTES);
        hipOccupancyMaxActiveBlocksPerMultiprocessor(&per_cu, (const void*)fwd_megakernel, NTHR, LDS_BYTES);
        if (per_cu < 1) { fprintf(stderr, "kernel_launch: occupancy query says %d blocks/CU\n", per_cu); per_cu = 1; }
        (void)hipGetLastError();
        grid = cus;
    }
    if (grid < 0) return;
    if (hipMemsetAsync(d_ws, 0, CTL_ZERO, stream) != hipSuccess) { fprintf(stderr, "kernel_launch: memset failed\n"); return; }
    Args a{};
    for (int i = 0; i < 43; ++i) a.in[i] = (const float*)d_in[i];
    a.out = (float*)d_out; a.ws = (unsigned char*)d_ws; a.ph_lo = 0; a.ph_hi = PH_COUNT;
    void* kargs[] = {&a};
    hipError_t e = hipLaunchCooperativeKernel((const void*)fwd_megakernel, dim3(grid), dim3(NTHR), kargs, LDS_BYTES, stream);
    if (e != hipSuccess) fprintf(stderr, "cooperative launch failed: %s (grid %d)\n", hipGetErrorString(e), grid);
}
```
